# Optimizing an MI355X kernel written in HIP

```python
import jax, jax.numpy as jnp
from jax import lax
import numpy as np

D_MODEL = 1024
BATCH = 8
SEQ = 4096
DEPTH = 2

HEAD_DIM = 64
ATTN_WIDTH = D_MODEL // 2
ATTN_HEADS = ATTN_WIDTH // HEAD_DIM
POOL_WIDTH = D_MODEL - ATTN_WIDTH
POOL_WINDOWS = (2, 4, 8, 16)
POOL_GROUPS = len(POOL_WINDOWS)
POOL_GROUP_DIM = POOL_WIDTH // POOL_GROUPS
MIX_WIDTH = ATTN_WIDTH + POOL_WIDTH
IN_WIDTH = 3 * ATTN_WIDTH + POOL_WIDTH
MOBA_BLOCK = 256
MOBA_TOP_K = 3
Q_CHUNK = 32
ROPE_THETA = 500000.0
ROT_DIM = HEAD_DIM // 4
D_FF = ((8 * D_MODEL // 3 + 255) // 256) * 256
CONV_WIDTH = 3
NORM_EPS = 1e-6
NEG_INF = -1e30

kernel_name = "hybrid_moba_pool_convffn_adaln"


def rms_norm(x, gain):
    xf = x.astype(jnp.float32)
    y = xf * lax.rsqrt(jnp.mean(xf * xf, axis=-1, keepdims=True) + NORM_EPS)
    return (y * gain.astype(jnp.float32)).astype(x.dtype)


def partial_rotary(x, cos, sin):
    half = ROT_DIM // 2
    x1 = x[..., :half]
    x2 = x[..., half:ROT_DIM]
    return jnp.concatenate([x1 * cos - x2 * sin, x2 * cos + x1 * sin, x[..., ROT_DIM:]], axis=-1)


def moba_attention(q, k, v):
    b, h, s, d = q.shape
    nb = -(-s // MOBA_BLOCK)
    pad = nb * MOBA_BLOCK - s
    kb = jnp.pad(k, ((0, 0), (0, 0), (0, pad), (0, 0))).reshape(b, h, nb, MOBA_BLOCK, d)
    vb = jnp.pad(v, ((0, 0), (0, 0), (0, pad), (0, 0))).reshape(b, h, nb, MOBA_BLOCK, d)
    kmean = jnp.mean(kb.astype(jnp.float32), axis=3)
    pos = jnp.arange(s)
    qblk = pos // MOBA_BLOCK
    gate = jnp.einsum('bhsd,bhnd->bhsn', q.astype(jnp.float32), kmean)
    past = jnp.arange(nb)[None, :] < qblk[:, None]
    gate = jnp.where(past, gate, NEG_INF)
    k_sel = min(MOBA_TOP_K, nb)
    _, top_idx = lax.top_k(gate, k_sel)
    top_valid = top_idx < qblk[:, None]
    own = jnp.broadcast_to(qblk[None, None, :, None], (b, h, s, 1))
    sel = jnp.concatenate([top_idx.astype(jnp.int32), own.astype(jnp.int32)], axis=-1)
    slot_valid = jnp.concatenate([top_valid, jnp.ones((b, h, s, 1), dtype=bool)], axis=-1)
    nc = s // Q_CHUNK

    def to_chunks(a):
        return jnp.moveaxis(a.reshape(b, h, nc, Q_CHUNK, *a.shape[3:]), 2, 0)

    bi = jnp.arange(b)[:, None, None, None]
    hi = jnp.arange(h)[None, :, None, None]
    offs = jnp.arange(MOBA_BLOCK)
    scale = d ** -0.5

    def chunk_fn(args):
        qc, selc, validc, tc = args
        kg = kb[bi, hi, selc]
        vg = vb[bi, hi, selc]
        sc = jnp.einsum('bhcd,bhcnkd->bhcnk', qc, kg).astype(jnp.float32) * scale
        kpos = selc[..., None] * MOBA_BLOCK + offs
        mask = validc[..., None] & (kpos <= tc[None, None, :, None, None])
        sc = jnp.where(mask, sc, NEG_INF)
        p = jax.nn.softmax(sc.reshape(b, h, Q_CHUNK, -1), axis=-1).reshape(sc.shape)
        return jnp.einsum('bhcnk,bhcnkd->bhcd', p.astype(vg.dtype), vg)

    out = lax.map(chunk_fn, (to_chunks(q), to_chunks(sel), to_chunks(slot_valid),
                             pos.reshape(nc, Q_CHUNK)))
    return jnp.moveaxis(out, 0, 2).reshape(b, h, s, d)


def multiscale_pool(p, w_pool, pool_scale):
    b, s, _ = p.shape
    pf = p.astype(jnp.float32)
    cs = jnp.pad(jnp.cumsum(pf, axis=1), ((0, 0), (1, 0), (0, 0)))
    t = jnp.arange(s)
    outs = []
    for g, w in enumerate(POOL_WINDOWS):
        sl = slice(g * POOL_GROUP_DIM, (g + 1) * POOL_GROUP_DIM)
        cg = cs[:, :, sl]
        lower = jnp.pad(cg[:, :s + 1 - w], ((0, 0), (w - 1, 0), (0, 0)))
        count = jnp.minimum(t + 1, w).astype(jnp.float32)[None, :, None]
        outs.append((cg[:, 1:] - lower) / count - pf[:, :, sl])
    pooled = jnp.stack(outs, axis=2).astype(p.dtype)
    y = jnp.einsum('bsgc,gce->bsge', pooled, w_pool).reshape(b, s, POOL_WIDTH)
    return y * pool_scale


def conv_glu_ffn(h, w_up, conv_w, conv_b, w_down):
    u = h @ w_up
    s = u.shape[1]
    up = jnp.pad(u, ((0, 0), (CONV_WIDTH - 1, 0), (0, 0)))
    uc = conv_b + conv_w[0] * up[:, 0:s]
    for j in range(1, CONV_WIDTH):
        uc = uc + conv_w[j] * up[:, j:j + s]
    a, g = jnp.split(uc, 2, axis=-1)
    return (jax.nn.silu(a) * g) @ w_down


def setup_inputs(seed: int = 0) -> dict:
    key = jax.random.key(seed)
    ks = jax.random.split(key, 20)
    f32 = jnp.float32
    L, D = DEPTH, D_MODEL

    def nrm(k, shape, fan_in):
        return jax.random.normal(k, shape, f32) * (fan_in ** -0.5)

    def gain(k, shape):
        return 1.0 + 0.05 * jax.random.normal(k, shape, f32)

    return {
        "x": jax.random.normal(ks[0], (BATCH, SEQ, D), f32),
        "c": jax.random.normal(ks[1], (BATCH, D), f32),
        "w_ada": nrm(ks[2], (L, D, 6 * D), D),
        "b_ada": 0.02 * jax.random.normal(ks[3], (L, 6 * D), f32),
        "g_pre_mix": gain(ks[4], (L, D)),
        "w_in": nrm(ks[5], (L, D, IN_WIDTH), D),
        "w_pool": nrm(ks[6], (L, POOL_GROUPS, POOL_GROUP_DIM, POOL_GROUP_DIM), POOL_GROUP_DIM),
        "pool_scale": gain(ks[7], (L, POOL_WIDTH)),
        "attn_out_gain": gain(ks[8], (L, ATTN_WIDTH)),
        "pool_out_gain": gain(ks[9], (L, POOL_WIDTH)),
        "w_out": nrm(ks[10], (L, MIX_WIDTH, D), MIX_WIDTH),
        "g_post_mix": gain(ks[11], (L, D)),
        "g_pre_ffn": gain(ks[12], (L, D)),
        "w_up": nrm(ks[13], (L, D, 2 * D_FF), D),
        "conv_w": nrm(ks[14], (L, CONV_WIDTH, 2 * D_FF), CONV_WIDTH),
        "conv_b": 0.02 * jax.random.normal(ks[15], (L, 2 * D_FF), f32),
        "w_down": nrm(ks[16], (L, D_FF, D), D_FF),
        "g_post_ffn": gain(ks[17], (L, D)),
    }


def reference(x, c, w_ada, b_ada, g_pre_mix, w_in, w_pool, pool_scale, attn_out_gain,
              pool_out_gain, w_out, g_post_mix, g_pre_ffn, w_up, conv_w, conv_b, w_down,
              g_post_ffn):
    b, s, _ = x.shape
    pos = jnp.arange(s, dtype=jnp.float32)
    inv_freq = jnp.power(jnp.float32(ROPE_THETA),
                         -jnp.arange(0, ROT_DIM, 2, dtype=jnp.float32) / ROT_DIM)
    ang = pos[:, None] * inv_freq[None, :]
    cos = jnp.cos(ang).astype(x.dtype)
    sin = jnp.sin(ang).astype(x.dtype)
    c_act = jax.nn.silu(c)

    def heads(t):
        return t.reshape(b, s, ATTN_HEADS, HEAD_DIM).transpose(0, 2, 1, 3)

    for l in range(DEPTH):
        mod = c_act @ w_ada[l] + b_ada[l]
        sh1, sc1, gt1, sh2, sc2, gt2 = jnp.split(mod, 6, axis=-1)

        h = rms_norm(x, g_pre_mix[l]) * (1.0 + sc1[:, None]) + sh1[:, None]
        z = h @ w_in[l]
        q = z[..., 0:ATTN_WIDTH]
        k = z[..., ATTN_WIDTH:2 * ATTN_WIDTH]
        v = z[..., 2 * ATTN_WIDTH:3 * ATTN_WIDTH]
        pz = z[..., 3 * ATTN_WIDTH:]
        qh = partial_rotary(heads(q), cos, sin)
        kh = partial_rotary(heads(k), cos, sin)
        ao = moba_attention(qh, kh, heads(v)).transpose(0, 2, 1, 3).reshape(b, s, ATTN_WIDTH)
        po = multiscale_pool(pz, w_pool[l], pool_scale[l])
        merged = jnp.concatenate([rms_norm(ao, attn_out_gain[l]),
                                  rms_norm(po, pool_out_gain[l])], axis=-1)
        y = merged @ w_out[l]
        x = x + gt1[:, None] * rms_norm(y, g_post_mix[l])

        h = rms_norm(x, g_pre_ffn[l]) * (1.0 + sc2[:, None]) + sh2[:, None]
        y = conv_glu_ffn(h, w_up[l], conv_w[l], conv_b[l], w_down[l])
        x = x + gt2[:, None] * rms_norm(y, g_post_ffn[l])
    return x
```

```cpp
#include <hip/hip_runtime.h>
#include <cstdio>
#include <cstdint>
#include <cmath>

#ifndef OPT_INPROJ
#define OPT_INPROJ 1
#endif
#ifndef OPT_ATTN
#define OPT_ATTN 1
#endif
#ifndef OPT_FFN
#define OPT_FFN 1
#endif
#ifndef OPT_POOL
#define OPT_POOL 1
#endif
#ifndef ONE_LAUNCH
#define ONE_LAUNCH 1
#endif

constexpr int BATCH = 8, SEQ = 4096, DM = 1024, M = BATCH * SEQ, DEPTH = 2;
constexpr int AW = 512, NH = 8, HD = 64, PW = 512, INW = 2048, FF = 2816, FF2 = 5632, NBLK = 16, MBLK = 256;
constexpr float NORM_EPS = 1e-6f;
constexpr float QSCALE = 0.125f * 1.4426950408889634f;

namespace pg8 {
#define PG8_LAS __attribute__((address_space(3)))
typedef unsigned short f16_t;
typedef _Float16 h16x8 __attribute__((ext_vector_type(8)));
typedef _Float16 h16x2 __attribute__((ext_vector_type(2)));
typedef float f32x4 __attribute__((ext_vector_type(4)));
typedef float f32x2 __attribute__((ext_vector_type(2)));
typedef unsigned u32x4 __attribute__((ext_vector_type(4)));
constexpr int BM = 256, BK = 64, HALF = 128, HTB = HALF * BK * 2  , STAGE_BYTES = 8 * HTB, NXCD = 8, WGM = 8;

__host__ __device__ __forceinline__ int lds_byte(int r, int c) { const int st = (r >> 4) * 2 + (c >> 5), rr = r & 15, cc = c & 31, ob = rr * 64 + cc * 2; return st * 1024 + (ob ^ (((ob >> 9) & 1) << 5)); }
__host__ __device__ __forceinline__ void stage_rc(int b, int& R, int& C) { const int st = b / 1024, sb = b % 1024, swz = sb ^ (((sb >> 9) & 1) << 5); R = (st >> 1) * 16 + swz / 64; C = (st & 1) * 32 + (swz % 64) / 2; }
__host__ __device__ __forceinline__ int perm32(int rho) { const int n = rho >> 4, i = rho & 15; return 8 * (i >> 2) + 4 * n + (i & 3); }

struct Unit { int pm, pn; };
struct Gemm { const f16_t* A; const f16_t* Bt; int M, N, K; };

struct StaticOrder {
    int nM, nN, nwg, G, c;
    __host__ __device__ void init(int M_, int N_, int G_, int c_) { nM = M_ / BM; nN = N_ / BM; nwg = nM * nN; G = G_; c = c_; }
    __host__ __device__ bool next(int i, Unit& u) const {
        const long L = (long)i * G + c; if (L >= nwg) return false;
        int wgid = (int)L; { const int q = nwg / NXCD, r = nwg % NXCD, xcd = wgid % NXCD, off = wgid / NXCD; wgid = (xcd < r ? xcd * (q + 1) : r * (q + 1) + (xcd - r) * q) + off; }
        const int nig = WGM * nN, gid = wgid / nig, fm = gid * WGM, gsz = (nM - fm) < WGM ? (nM - fm) : WGM;
        u.pm = fm + ((wgid % nig) % gsz); u.pn = (wgid % nig) / gsz; return true;
    }
    __device__ __forceinline__ void a_ready(const Unit&) const {}
    __device__ __forceinline__ void done(const Unit&) const {}
};

__device__ __forceinline__ unsigned cvt_pk_f16(float lo, float hi) { const f32x2 v = {lo, hi}; const h16x2 h = __builtin_convertvector(v, h16x2); return __builtin_bit_cast(unsigned, h); }

struct EpiF16 {
    static constexpr bool PERM = true, AFTER_DRAIN = false, APERM = false;
    f16_t* O; int ldc; int split_cols; size_t split_stride;
    __device__ __forceinline__ void operator()(const f32x4 (&acc)[2][2][4][2], const Unit& u, int wr, int wc, int fr, int fq) const {
        const int row0 = u.pm * BM + wr * 64 + fr; int colt = u.pn * BM; f16_t* base = O;
        if (split_cols) { const int t = colt / split_cols; base += (size_t)t * split_stride; colt -= t * split_cols; }
        const int col0 = colt + wc * 32 + 8 * fq;
#pragma unroll
        for (int ai = 0; ai < 2; ++ai)
#pragma unroll
            for (int m = 0; m < 4; ++m) { f16_t* rowp = base + (size_t)(row0 + ai * HALF + m * 16) * ldc + col0;
#pragma unroll
                for (int bj = 0; bj < 2; ++bj) { const f32x4 v0 = acc[ai][bj][m][0], v1 = acc[ai][bj][m][1];
                    u32x4 w; w.x = cvt_pk_f16(v0[0], v0[1]); w.y = cvt_pk_f16(v0[2], v0[3]); w.z = cvt_pk_f16(v1[0], v1[1]); w.w = cvt_pk_f16(v1[2], v1[3]);
                    *(u32x4*)(rowp + bj * HALF) = w; } }
    }
};

struct EpiIn {
    static constexpr bool PERM = true, AFTER_DRAIN = false, APERM = false;
    f16_t* QKVR; const float* ROPE; float* KP; float qscale;
    __device__ __forceinline__ void operator()(const f32x4 (&acc)[2][2][4][2], const Unit& u, int wr, int wc, int fr, int fq) const {
        const int t = u.pn >> 1; f16_t* base = QKVR + (size_t)t * (size_t)(16u << 20);
        const int col0 = (u.pn & 1) * 256 + wc * 32 + 8 * fq, row0 = u.pm * BM + wr * 64 + fr;
        const bool rot = (t < 2) && ((wc & 1) == 0);
        const float sgn = fq == 0 ? -1.f : 1.f; const bool rl = fq < 2; const float qs = t == 0 ? qscale : 1.f;
        f32x4 ks[2][2];
#pragma unroll
        for (int bj = 0; bj < 2; ++bj)
#pragma unroll
            for (int n = 0; n < 2; ++n) ks[bj][n] = (f32x4){0.f, 0.f, 0.f, 0.f};
        f32x4 rn[4];
#pragma unroll
        for (int i = 0; i < 4; ++i) rn[i] = (f32x4){0.f, 0.f, 0.f, 0.f};
        if (rot) { const float* rp = ROPE + (size_t)(row0 & 4095) * 16;
#pragma unroll
            for (int i = 0; i < 4; ++i) rn[i] = *(const f32x4*)(rp + 4 * i); }
#pragma unroll
        for (int ai = 0; ai < 2; ++ai)
#pragma unroll
            for (int m = 0; m < 4; ++m) { const int row = row0 + ai * HALF + m * 16;
                f32x4 rc[4];
#pragma unroll
                for (int i = 0; i < 4; ++i) rc[i] = rn[i];
                if (rot && !(ai == 1 && m == 3)) { const int rown = (m == 3) ? row0 + HALF : row + 16; const float* rp = ROPE + (size_t)(rown & 4095) * 16;
#pragma unroll
                    for (int i = 0; i < 4; ++i) rn[i] = *(const f32x4*)(rp + 4 * i); }
                f32x4 v[2][2];
#pragma unroll
                for (int bj = 0; bj < 2; ++bj)
#pragma unroll
                    for (int n = 0; n < 2; ++n) v[bj][n] = acc[ai][bj][m][n];
                if (rot) { f32x4 cs[2], sn[2]; cs[0] = rc[0]; cs[1] = rc[1]; sn[0] = rc[2]; sn[1] = rc[3];
#pragma unroll
                    for (int bj = 0; bj < 2; ++bj)
#pragma unroll
                        for (int n = 0; n < 2; ++n)
#pragma unroll
                            for (int e = 0; e < 4; ++e) { const float x = v[bj][n][e], px = __shfl_xor(x, 16); const float r = x * cs[n][e] + sgn * px * sn[n][e]; v[bj][n][e] = rl ? r : x; } }
                if (t == 1) {
#pragma unroll
                    for (int bj = 0; bj < 2; ++bj)
#pragma unroll
                        for (int n = 0; n < 2; ++n) ks[bj][n] += v[bj][n];
                }
                f16_t* rowp = base + (size_t)row * 512 + col0;
#pragma unroll
                for (int bj = 0; bj < 2; ++bj) { const f32x4 v0 = v[bj][0] * qs, v1 = v[bj][1] * qs;
                    u32x4 w; w.x = cvt_pk_f16(v0[0], v0[1]); w.y = cvt_pk_f16(v0[2], v0[3]); w.z = cvt_pk_f16(v1[0], v1[1]); w.w = cvt_pk_f16(v1[2], v1[3]);
                    *(u32x4*)(rowp + bj * HALF) = w; }
                asm volatile("" ::: "memory"); __builtin_amdgcn_sched_barrier(0);
            }
        if (t == 1) {
#pragma unroll
            for (int bj = 0; bj < 2; ++bj)
#pragma unroll
                for (int n = 0; n < 2; ++n) { f32x4 s = ks[bj][n];
#pragma unroll
                    for (int o = 1; o < 16; o <<= 1) { s.x += __shfl_xor(s.x, o); s.y += __shfl_xor(s.y, o); s.z += __shfl_xor(s.z, o); s.w += __shfl_xor(s.w, o); }
                    if (fr == 0) *(f32x4*)(KP + ((size_t)(wr * 128 + u.pm)) * 512 + (u.pn & 1) * 256 + bj * HALF + wc * 32 + 8 * fq + 4 * n) = s; }
        }
    }
};

__device__ __forceinline__ float dpp_row_shr1(float v) { return __builtin_bit_cast(float, __builtin_amdgcn_update_dpp(0, __builtin_bit_cast(int, v), 0x111, 0xF, 0xF, true)); }
__device__ __forceinline__ float dpp_row_ror1(float v) { return __builtin_bit_cast(float, __builtin_amdgcn_update_dpp(0, __builtin_bit_cast(int, v), 0x121, 0xF, 0xF, true)); }
__device__ __forceinline__ f32x4 shr1_4(f32x4 v) { return (f32x4){dpp_row_shr1(v.x), dpp_row_shr1(v.y), dpp_row_shr1(v.z), dpp_row_shr1(v.w)}; }
__device__ __forceinline__ f32x4 ror1_4(f32x4 v) { return (f32x4){dpp_row_ror1(v.x), dpp_row_ror1(v.y), dpp_row_ror1(v.z), dpp_row_ror1(v.w)}; }
__device__ __forceinline__ float silu1(float a) { return a * __builtin_amdgcn_rcpf(1.0f + __builtin_amdgcn_exp2f(-1.4426950408889634f * a)); }
__device__ __forceinline__ f32x2 silu_mul2(f32x2 a, f32x2 g) { const f32x2 t = a * (-1.4426950408889634f); f32x2 e; e.x = __builtin_amdgcn_exp2f(t.x); e.y = __builtin_amdgcn_exp2f(t.y);
    const f32x2 d = e + 1.0f; f32x2 r; r.x = __builtin_amdgcn_rcpf(d.x); r.y = __builtin_amdgcn_rcpf(d.y); return (a * g) * r; }
struct EpiUp {
    static constexpr bool PERM = true, AFTER_DRAIN = false, APERM = true;
    f16_t* ACT; float* BND; const float* cw; const float* cb;
    PG8_LAS float* cwl;
    __device__ __forceinline__ void operator()(const f32x4 (&acc)[2][2][4][2], const Unit& u, int wr, int wc, int fr, int fq) const {
        const int j0 = u.pn * 128 + wc * 32 + 8 * fq;
        const int grp = 2 * u.pm + wr;
        PG8_LAS float* slot = cwl + (wr * 4 + wc) * 256;
        { const int lane = fq * 16 + fr, vec = lane >> 4, bjl = (lane >> 3) & 1, c4 = (lane & 7) * 4; const float* src = (vec < 3 ? cw + vec * 5632 : cb) + bjl * 2816 + u.pn * 128 + wc * 32 + c4;
          *(PG8_LAS f32x4*)(slot + vec * 64 + bjl * 32 + c4) = *(const f32x4*)src; }
        if (fr == 0 || fr == 15) {
#pragma unroll
            for (int mm = 0; mm < 2; ++mm) { const int m = fr == 0 ? mm : 2 + mm;
#pragma unroll
                for (int bj = 0; bj < 2; ++bj)
#pragma unroll
                    for (int n = 0; n < 2; ++n) { const f32x4 v = fr == 0 ? acc[0][bj][mm][n] : acc[1][bj][2 + mm][n]; *(f32x4*)(BND + ((size_t)grp * 4 + m) * 5632 + bj * 2816 + j0 + 4 * n) = v; } } }
#pragma unroll
        for (int aii = 0; aii < 2; ++aii) { const int ai = 1 - aii;
            unsigned pk0[4][2];
#pragma unroll
            for (int n = 0; n < 2; ++n) {
                f32x4 ua[4];
#pragma unroll
                for (int bj = 0; bj < 2; ++bj) {
                    const PG8_LAS float* sp = slot + bj * 32 + 8 * fq + 4 * n;
                    const f32x4 w0 = *(const PG8_LAS f32x4*)sp, w1 = *(const PG8_LAS f32x4*)(sp + 64), w2 = *(const PG8_LAS f32x4*)(sp + 128), b4 = *(const PG8_LAS f32x4*)(sp + 192);
                    const f32x4 U0 = acc[ai][bj][0][n], U1 = acc[ai][bj][1][n], U2 = acc[ai][bj][2][n], U3 = acc[ai][bj][3][n];
                    f32x4 P2, P3;
                    if (ai == 0) { P2 = shr1_4(U2); P3 = shr1_4(U3); }
                    else { const f32x4 S2 = fr == 15 ? acc[0][bj][2][n] : U2, S3 = fr == 15 ? acc[0][bj][3][n] : U3; P2 = ror1_4(S2); P3 = ror1_4(S3); }
                    f32x4 uc[4];
                    uc[0] = b4 + w0 * P2 + w1 * P3 + w2 * U0;
                    uc[1] = b4 + w0 * P3 + w1 * U0 + w2 * U1;
                    uc[2] = b4 + w0 * U0 + w1 * U1 + w2 * U2;
                    uc[3] = b4 + w0 * U1 + w1 * U2 + w2 * U3;
                    if (bj == 0) {
#pragma unroll
                        for (int m = 0; m < 4; ++m) ua[m] = uc[m];
                    } else {
#pragma unroll
                        for (int m = 0; m < 4; ++m) { const f32x4 a4 = ua[m], g4 = uc[m];
                            const f32x2 o01 = silu_mul2((f32x2){a4.x, a4.y}, (f32x2){g4.x, g4.y}), o23 = silu_mul2((f32x2){a4.z, a4.w}, (f32x2){g4.z, g4.w});
                            const unsigned p0 = cvt_pk_f16(o01.x, o01.y), p1 = cvt_pk_f16(o23.x, o23.y);
                            if (n == 0) { pk0[m][0] = p0; pk0[m][1] = p1; }
                            else { const size_t row = (size_t)grp * 128 + 64 * ai + 4 * fr + m; u32x4 w; w.x = pk0[m][0]; w.y = pk0[m][1]; w.z = p0; w.w = p1;
                                if (!(ai == 0 && m < 2 && fr == 0)) *(u32x4*)(ACT + row * 2816 + j0) = w; } }
                    }
                    asm volatile("" ::: "memory"); __builtin_amdgcn_sched_barrier(0);
                }
            }
        }
    }
};
template <class Epi, class Sched, bool ALIGN_EPI = false, bool SP2 = false>
__device__ __forceinline__ void gemm_phase(PG8_LAS unsigned char* lds, const Gemm g, const Sched& S, const Epi& E) {
    const int tid = threadIdx.x, wid = __builtin_amdgcn_readfirstlane(tid >> 6), lane = tid & 63, wr = wid >> 2, wc = wid & 3, fr = lane & 15, fq = lane >> 4;
    const int K = g.K, nt = K / BK;
    unsigned voffA[2], voffB[2];
#pragma unroll
    for (int i = 0; i < 2; ++i) { int R, C; stage_rc(tid * 16 + i * 8192, R, C); const int Rb = Epi::PERM ? ((R & ~31) + perm32(R & 31)) : R;
        const int Ra = Epi::APERM ? (128 * (R >> 6) + 4 * (R & 15) + ((R >> 4) & 3)) : R;
        voffA[i] = (unsigned)(Ra * K + C) * 2u; voffB[i] = (unsigned)(Rb * K + C) * 2u; }
    const size_t kstep = (size_t)(BK * 2);
    const size_t hstepB = (size_t)HALF * K * 2;
    const size_t hstepA = Epi::APERM ? (size_t)64 * K * 2 : hstepB;
    const size_t tstep = 2 * hstepB;
    const unsigned ldsw = (unsigned)wid * 1024u;
    const int aoff = lds_byte(wr * 64 + fr, fq * 8), boff = lds_byte(wc * 32 + fr, fq * 8);
#define PG8_SA(b, h) (((b) * 2 + (h)) * HTB)
#define PG8_SB(b, h) ((4 + (b) * 2 + (h)) * HTB)
#define PG8_STAGE(bufoff, gbase, voff) do { _Pragma("unroll") for (int _i = 0; _i < 2; ++_i) \
        __builtin_amdgcn_global_load_lds((const unsigned*)((const char*)(gbase) + (voff)[_i]), (PG8_LAS unsigned*)(lds + (bufoff) + ldsw + _i * 8192), 16, 0, 0); } while (0)
#define PG8_LDA(dst, b, h) do { _Pragma("unroll") for (int m = 0; m < 4; ++m) _Pragma("unroll") for (int k = 0; k < 2; ++k) dst[m][k] = *(const PG8_LAS h16x8*)(lds + PG8_SA(b, h) + aoff + m * 2048 + k * 1024); } while (0)
#define PG8_LDB(dst, b, h) do { _Pragma("unroll") for (int n = 0; n < 2; ++n) _Pragma("unroll") for (int k = 0; k < 2; ++k) dst[n][k] = *(const PG8_LAS h16x8*)(lds + PG8_SB(b, h) + boff + n * 2048 + k * 1024); } while (0)
#define PG8_MMA(ai, bj, At, Bt) do { __builtin_amdgcn_s_setprio(1); _Pragma("unroll") for (int m = 0; m < 4; ++m) _Pragma("unroll") for (int n = 0; n < 2; ++n) _Pragma("unroll") for (int k = 0; k < 2; ++k) \
        acc[ai][bj][m][n] = __builtin_amdgcn_mfma_f32_16x16x32_f16(Bt[n][k], At[m][k], acc[ai][bj][m][n], 0, 0, 0); __builtin_amdgcn_s_setprio(0); } while (0)
#define PG8_WAIT_V(n) asm volatile("s_waitcnt vmcnt(" #n ")" ::: "memory")
#define PG8_WAIT_L(n) asm volatile("s_waitcnt lgkmcnt(" #n ")" ::: "memory")
#define PG8_BAR __builtin_amdgcn_s_barrier()
#define PG8_SCHED __builtin_amdgcn_sched_barrier(0)
    Unit cur, nxt; int ui = 0;
    if (!S.next(0, cur)) return;
    f32x4 acc[2][2][4][2];
#pragma unroll
    for (int a = 0; a < 2; ++a)
#pragma unroll
        for (int b = 0; b < 2; ++b)
#pragma unroll
            for (int m = 0; m < 4; ++m)
#pragma unroll
                for (int n = 0; n < 2; ++n) acc[a][b][m][n] = (f32x4){0.f, 0.f, 0.f, 0.f};
    h16x8 At[4][2], B0[2][2], B1[2][2];
    const char* cA = (const char*)g.A + (size_t)cur.pm * tstep; const char* cB = (const char*)g.Bt + (size_t)cur.pn * tstep;
    S.a_ready(cur);
    if constexpr (SP2) {
        PG8_STAGE(PG8_SB(0, 0), cB, voffB); PG8_STAGE(PG8_SB(0, 1), cB + hstepB, voffB); PG8_STAGE(PG8_SA(0, 0), cA, voffA); PG8_STAGE(PG8_SA(0, 1), cA + hstepA, voffA);
        if (wr == 1) PG8_BAR;
        PG8_WAIT_V(2); PG8_BAR;
        PG8_STAGE(PG8_SB(1, 0), cB + kstep, voffB); PG8_STAGE(PG8_SA(1, 0), cA + kstep, voffA); PG8_STAGE(PG8_SB(1, 1), cB + hstepB + kstep, voffB);
        PG8_WAIT_V(6); PG8_BAR;
    } else {
        PG8_STAGE(PG8_SB(0, 0), cB, voffB); PG8_STAGE(PG8_SA(0, 0), cA, voffA); PG8_STAGE(PG8_SB(0, 1), cB + hstepB, voffB); PG8_STAGE(PG8_SA(0, 1), cA + hstepA, voffA);
        if (wr == 1) PG8_BAR;
        PG8_WAIT_V(4); PG8_BAR;
        PG8_STAGE(PG8_SB(1, 0), cB + kstep, voffB); PG8_STAGE(PG8_SA(1, 0), cA + kstep, voffA); PG8_STAGE(PG8_SB(1, 1), cB + hstepB + kstep, voffB);
        PG8_WAIT_V(6); PG8_BAR;
    }
    for (;;) {
        const bool has_next = S.next(ui + 1, nxt);
        const char* nA = has_next ? (const char*)g.A + (size_t)nxt.pm * tstep : cA; const char* nB = has_next ? (const char*)g.Bt + (size_t)nxt.pn * tstep : cB;
        for (int t = 0; t < nt; t += 2) {
            const bool last = (t == nt - 2);
            const char* a1 = cA + (size_t)(t + 1) * kstep;
            const char* a2 = last ? nA : cA + (size_t)(t + 2) * kstep; const char* b2 = last ? nB : cB + (size_t)(t + 2) * kstep;
            const char* a3 = a2 + kstep; const char* b3 = b2 + kstep;
            if (last && has_next) S.a_ready(nxt);
            if constexpr (SP2) {
            PG8_LDB(B0, 0, 0); PG8_LDB(B1, 0, 1); PG8_SCHED; PG8_LDA(At, 0, 0); PG8_STAGE(PG8_SA(1, 1), a1 + hstepA, voffA);
            PG8_WAIT_V(8); PG8_WAIT_L(0); PG8_BAR; PG8_MMA(0, 0, At, B0); PG8_MMA(0, 1, At, B1); PG8_BAR; PG8_SCHED;
            PG8_LDA(At, 0, 1); PG8_STAGE(PG8_SB(0, 0), b2, voffB); PG8_STAGE(PG8_SB(0, 1), b2 + hstepB, voffB); PG8_STAGE(PG8_SA(0, 0), a2, voffA);
            PG8_WAIT_V(8); PG8_WAIT_L(0); PG8_BAR; PG8_MMA(1, 0, At, B0); PG8_MMA(1, 1, At, B1); PG8_BAR; PG8_SCHED;
            PG8_LDB(B0, 1, 0); PG8_LDB(B1, 1, 1); PG8_SCHED; PG8_LDA(At, 1, 0); PG8_STAGE(PG8_SA(0, 1), a2 + hstepA, voffA);
            PG8_WAIT_V(8); PG8_WAIT_L(0); PG8_BAR; PG8_MMA(0, 0, At, B0); PG8_MMA(0, 1, At, B1); PG8_BAR; PG8_SCHED;
            PG8_LDA(At, 1, 1); PG8_STAGE(PG8_SB(1, 0), b3, voffB); PG8_STAGE(PG8_SB(1, 1), b3 + hstepB, voffB); PG8_STAGE(PG8_SA(1, 0), a3, voffA);
            PG8_WAIT_V(8); PG8_WAIT_L(0); PG8_BAR; PG8_MMA(1, 0, At, B0); PG8_MMA(1, 1, At, B1); PG8_BAR; PG8_SCHED;
            } else {
            PG8_LDB(B0, 0, 0); PG8_SCHED; PG8_LDA(At, 0, 0); PG8_STAGE(PG8_SA(1, 1), a1 + hstepA, voffA);
            PG8_WAIT_L(8); PG8_BAR; PG8_WAIT_L(0); PG8_MMA(0, 0, At, B0); PG8_BAR; PG8_SCHED;
            PG8_LDB(B1, 0, 1); PG8_STAGE(PG8_SB(0, 0), b2, voffB);
            PG8_BAR; PG8_WAIT_L(0); PG8_MMA(0, 1, At, B1); PG8_BAR;
            PG8_LDA(At, 0, 1); PG8_STAGE(PG8_SA(0, 0), a2, voffA);
            PG8_BAR; PG8_WAIT_L(0); PG8_MMA(1, 0, At, B0); PG8_BAR; PG8_SCHED;
            PG8_STAGE(PG8_SB(0, 1), b2 + hstepB, voffB);
            PG8_WAIT_V(6); PG8_BAR; PG8_MMA(1, 1, At, B1); PG8_BAR;
            PG8_LDB(B0, 1, 0); PG8_SCHED; PG8_LDA(At, 1, 0); PG8_STAGE(PG8_SA(0, 1), a2 + hstepA, voffA);
            PG8_WAIT_L(8); PG8_BAR; PG8_WAIT_L(0); PG8_MMA(0, 0, At, B0); PG8_BAR; PG8_SCHED;
            PG8_LDB(B1, 1, 1); PG8_STAGE(PG8_SB(1, 0), b3, voffB);
            PG8_BAR; PG8_WAIT_L(0); PG8_MMA(0, 1, At, B1); PG8_BAR;
            PG8_LDA(At, 1, 1); PG8_STAGE(PG8_SA(1, 0), a3, voffA);
            PG8_BAR; PG8_WAIT_L(0); PG8_MMA(1, 0, At, B0); PG8_BAR; PG8_SCHED;
            PG8_STAGE(PG8_SB(1, 1), b3 + hstepB, voffB);
            PG8_WAIT_V(6); PG8_BAR; PG8_MMA(1, 1, At, B1); PG8_BAR;
            }
        }
        if constexpr (ALIGN_EPI) { if (wr == 0) PG8_BAR; }
        if constexpr (!Epi::AFTER_DRAIN) { E(acc, cur, wr, wc, fr, fq); S.done(cur); }
        if (!has_next) break;
#pragma unroll
        for (int a = 0; a < 2; ++a)
#pragma unroll
            for (int b = 0; b < 2; ++b)
#pragma unroll
                for (int m = 0; m < 4; ++m)
#pragma unroll
                    for (int n = 0; n < 2; ++n) acc[a][b][m][n] = (f32x4){0.f, 0.f, 0.f, 0.f};
        cur = nxt; cA = nA; cB = nB; ++ui;
        if constexpr (ALIGN_EPI) { if (wr == 1) PG8_BAR; }
    }
    PG8_WAIT_V(0);
    if constexpr (!ALIGN_EPI) { if (wr == 0) PG8_BAR; }
    PG8_BAR;
    if constexpr (Epi::AFTER_DRAIN) { E.fused(acc, cur, wr, wc, fr, fq, lds, wid, lane); S.done(cur); }
#undef PG8_SA
#undef PG8_SB
#undef PG8_STAGE
#undef PG8_LDA
#undef PG8_LDB
#undef PG8_MMA
#undef PG8_WAIT_V
#undef PG8_WAIT_L
#undef PG8_BAR
#undef PG8_SCHED
}

}

constexpr size_t MiB = 1u << 20;
constexpr size_t WS_CTL = 0, CTL_ZERO_BYTES = 1 * MiB;
constexpr size_t WS_ROPE = 1 * MiB;
constexpr size_t WS_MOD = 1 * MiB + 512 * 1024;
constexpr size_t WS_KP = 2 * MiB;
constexpr size_t WS_BND = 3 * MiB;
constexpr size_t WS_W = 25 * MiB;
constexpr size_t W_IN = 0, W_OUT = 4 * MiB, W_UP = 6 * MiB, W_DOWN = 17 * MiB, W_LAYER = 22 * MiB + 512 * 1024;
constexpr size_t WS_H = 70 * MiB;
constexpr size_t WS_Y = 134 * MiB;
constexpr size_t WS_A = 198 * MiB;
constexpr size_t WS_Q = WS_A, WS_K = WS_A + 32 * MiB, WS_V = WS_A + 64 * MiB, WS_R = WS_A + 96 * MiB, WS_AO = WS_A + 128 * MiB, WS_MG = WS_A + 160 * MiB;
constexpr size_t WS_ACT = WS_A;
constexpr size_t WS_U = 422 * MiB;
constexpr size_t WS_X16 = 422 * MiB;
constexpr size_t WS_SEL = 490 * MiB;
constexpr size_t WS_END = 512 * MiB;
static_assert(WS_W + 2 * W_LAYER <= WS_H && WS_MG + 64 * MiB <= WS_U && WS_U + 44 * MiB <= WS_END, "d_ws map");
constexpr int CW_TMO = 0, CW_CODE = 1, CW_BAR = 4096;

constexpr int RING_OFF = 0, RING_BYTES = 131072;
constexpr int LDSCTL_OFF = RING_BYTES, MISC_OFF = LDSCTL_OFF + 320;
constexpr int LDS_BYTES = 147456;
constexpr int EPI_LDS_OFF = LDSCTL_OFF + 2048;
constexpr int NWAVES = 8;

#define GAS __attribute__((address_space(1)))
#define LAS __attribute__((address_space(3)))
typedef unsigned short f16_t;
typedef unsigned v4u __attribute__((ext_vector_type(4)));
typedef unsigned v2u __attribute__((ext_vector_type(2)));
typedef float f32x4 __attribute__((ext_vector_type(4)));
typedef float f32x2 __attribute__((ext_vector_type(2)));
typedef _Float16 h16x2 __attribute__((ext_vector_type(2)));
typedef GAS unsigned gu32;
#define RLX_AGENT __ATOMIC_RELAXED, __HIP_MEMORY_SCOPE_AGENT
#define LDS_WAIT() asm volatile("s_waitcnt lgkmcnt(0)" ::: "memory")
#define VM_WAIT() asm volatile("s_waitcnt vmcnt(0)" ::: "memory")
__device__ __forceinline__ unsigned pkh(float lo, float hi) { return pg8::cvt_pk_f16(lo, hi); }
__device__ __forceinline__ f32x2 unpk(unsigned w) { const h16x2 h = __builtin_bit_cast(h16x2, w); return __builtin_convertvector(h, f32x2); }
__device__ __forceinline__ float h2f(f16_t h) { return (float)__builtin_bit_cast(_Float16, h); }
__device__ __forceinline__ f16_t f2h(float f) { return __builtin_bit_cast(f16_t, (_Float16)f); }
__device__ __forceinline__ float wave_sum(float v) {
#pragma unroll
    for (int o = 1; o < 64; o <<= 1) v += __shfl_xor(v, o);
    return v;
}
__device__ __forceinline__ float wave_max(float v) {
#pragma unroll
    for (int o = 1; o < 64; o <<= 1) v = fmaxf(v, __shfl_xor(v, o));
    return v;
}
__device__ __forceinline__ float rsq(float x) { return __builtin_amdgcn_rsqf(x); }
__device__ __forceinline__ float silu_f(float a) { return a * __builtin_amdgcn_rcpf(1.0f + __builtin_amdgcn_exp2f(-1.4426950408889634f * a)); }
namespace attn_body {
using f16=_Float16;
using h16x8=__attribute__((ext_vector_type(8)))_Float16;
using s16x8=__attribute__((ext_vector_type(8)))short;
using s16x4=__attribute__((ext_vector_type(4)))short;
using f32x16=__attribute__((ext_vector_type(16)))float;
using u32x4=__attribute__((ext_vector_type(4)))unsigned;
constexpr int BATCH=8,NHEAD=8,SEQ=4096,D=64,DM=NHEAD*D;
constexpr int NW=8,QBLK=32,QB=QBLK*NW,KVBLK=64,NQB=SEQ/QB;
constexpr int ATTN_PITCH=DM, ATTN_UNIT_ROWS=QB;
__device__ __forceinline__ int crow(int r,int hi){return (r&3)+8*(r>>2)+4*hi;}
#define SBAR() __builtin_amdgcn_sched_barrier(0)
__device__ __forceinline__ void cmask(f32x16&p0,f32x16&p1,int jb,int qrel,int hi){
  const float NEG=-INFINITY; int kb=64*jb+4*hi;
  #pragma unroll
  for(int r=0;r<16;++r){int kv=kb+(r&3)+8*(r>>2); if(kv>qrel)p0[r]=NEG; if(kv+32>qrel)p1[r]=NEG;}
}

constexpr int NSLOT=3, SLOTB=8192;
constexpr int LDS_K=0, LDS_V=NSLOT*SLOTB, LDS_WS=2*NSLOT*SLOTB, LDS_OST=LDS_WS+NW*64*4, LDS_BYTES=LDS_OST+NW*4096;
constexpr float C2=0.125f*1.4426950408889634f;
__device__ __forceinline__ void glds16(const void*gsrc,unsigned lds_dst){unsigned keep;
  asm volatile("s_mov_b32 %0, m0\n\ts_mov_b32 m0, %2\n\ts_nop 0\n\tglobal_load_lds_dwordx4 %1, off\n\ts_mov_b32 m0, %0":"=&s"(keep):"v"(gsrc),"s"(lds_dst):"memory");}
__device__ __forceinline__ float max3f(float a,float b,float c){float r;asm("v_max3_f32 %0, %1, %2, %3":"=v"(r):"v"(a),"v"(b),"v"(c));return r;}
__device__ __forceinline__ float max2f(float a,float b){float r;asm("v_max_f32_e32 %0, %1, %2":"=v"(r):"v"(a),"v"(b));return r;}
__device__ __forceinline__ float fadd_s(float a,float b){float r;asm("v_add_f32_e32 %0, %1, %2":"=v"(r):"v"(a),"v"(b));return r;}
__device__ __forceinline__ float fsub_s(float a,float b){float r;asm("v_sub_f32_e32 %0, %1, %2":"=v"(r):"v"(a),"v"(b));return r;}
typedef float f32x2_t __attribute__((ext_vector_type(2))); typedef _Float16 h16x2_t __attribute__((ext_vector_type(2)));
__device__ __forceinline__ unsigned cvtpk_s(float lo,float hi){f32x2_t v={lo,hi};h16x2_t b=__builtin_convertvector(v,h16x2_t);return __builtin_bit_cast(unsigned,b);}
#define WAIT_BAR(N) asm volatile("s_waitcnt vmcnt(" #N ") lgkmcnt(0)\n\ts_barrier":::"memory")

__device__ __forceinline__ void qkt(f32x16&p0,f32x16&p1,const char*Kslot,const h16x8*qr,const f32x16&negm,int r32,int hi){
  const char*kb=Kslot+hi*1024+r32*16;
  #pragma unroll
  for(int d0=0;d0<4;++d0){
    const h16x8 b0=*reinterpret_cast<const h16x8*>(kb+d0*2048);
    const h16x8 b1=*reinterpret_cast<const h16x8*>(kb+d0*2048+512);
    if(d0==0){p0=__builtin_amdgcn_mfma_f32_32x32x16_f16(b0,qr[0],negm,0,0,0);p1=__builtin_amdgcn_mfma_f32_32x32x16_f16(b1,qr[0],negm,0,0,0);}
    else{p0=__builtin_amdgcn_mfma_f32_32x32x16_f16(b0,qr[d0],p0,0,0,0);p1=__builtin_amdgcn_mfma_f32_32x32x16_f16(b1,qr[d0],p1,0,0,0);}}
}
typedef __attribute__((address_space(3))) const char* lds_cptr;
typedef short v4i16_t __attribute__((ext_vector_type(4)));
__device__ __forceinline__ void kload8(h16x8*kf,lds_cptr kp){
  kf[0]=*(const __attribute__((address_space(3))) h16x8*)(kp);      kf[1]=*(const __attribute__((address_space(3))) h16x8*)(kp+512);
  kf[2]=*(const __attribute__((address_space(3))) h16x8*)(kp+2048); kf[3]=*(const __attribute__((address_space(3))) h16x8*)(kp+2560);
  kf[4]=*(const __attribute__((address_space(3))) h16x8*)(kp+4096); kf[5]=*(const __attribute__((address_space(3))) h16x8*)(kp+4608);
  kf[6]=*(const __attribute__((address_space(3))) h16x8*)(kp+6144); kf[7]=*(const __attribute__((address_space(3))) h16x8*)(kp+6656);
}
__device__ __forceinline__ void kload2(h16x8*kf,lds_cptr kp,int j){ kf[2*j]=*(const __attribute__((address_space(3))) h16x8*)(kp+j*2048); kf[2*j+1]=*(const __attribute__((address_space(3))) h16x8*)(kp+j*2048+512); }
__device__ __forceinline__ s16x4 vtr(lds_cptr p){ return __builtin_bit_cast(s16x4,__builtin_amdgcn_ds_read_tr16_b64_v4i16((__attribute__((address_space(3))) v4i16_t*)p)); }
__device__ __forceinline__ float rowmax(const f32x16&p0,const f32x16&p1){
  float a=max3f(p0[0],p0[1],p1[0]),b=max3f(p0[2],p0[3],p1[1]);a=max3f(a,p1[2],p1[3]);
  #pragma unroll
  for(int r=4;r<16;r+=4){a=max3f(a,p0[r],p0[r+1]);b=max3f(b,p0[r+2],p0[r+3]);a=max3f(a,p1[r],p1[r+1]);b=max3f(b,p1[r+2],p1[r+3]);}
  const float m=max2f(a,b);
  auto rr=__builtin_amdgcn_permlane32_swap(__float_as_uint(m),__float_as_uint(m),false,false);
  return max2f(__uint_as_float(rr[0]),__uint_as_float(rr[1]));
}
__device__ __forceinline__ void pv(f32x16*o,int vb,h16x8 pa0,h16x8 pa1,h16x8 pa2,h16x8 pa3){
  #pragma unroll
  for(int d0=0;d0<2;++d0){s16x4 lo[4],hi[4];
    #pragma unroll
    for(int ks=0;ks<4;++ks){
      asm volatile("ds_read_b64_tr_b16 %0,%1 offset:%c2":"=&v"(lo[ks]):"v"(vb),"i"(d0*4096+ks*1024):"memory");
      asm volatile("ds_read_b64_tr_b16 %0,%1 offset:%c2":"=&v"(hi[ks]):"v"(vb),"i"(d0*4096+ks*1024+512):"memory");}
    asm volatile("s_waitcnt lgkmcnt(0)":::"memory");SBAR();
    #define PK(k) __builtin_bit_cast(h16x8,(s16x8){lo[k][0],lo[k][1],lo[k][2],lo[k][3],hi[k][0],hi[k][1],hi[k][2],hi[k][3]})
    o[d0]=__builtin_amdgcn_mfma_f32_32x32x16_f16(pa0,PK(0),o[d0],0,0,0);
    o[d0]=__builtin_amdgcn_mfma_f32_32x32x16_f16(pa1,PK(1),o[d0],0,0,0);
    o[d0]=__builtin_amdgcn_mfma_f32_32x32x16_f16(pa2,PK(2),o[d0],0,0,0);
    o[d0]=__builtin_amdgcn_mfma_f32_32x32x16_f16(pa3,PK(3),o[d0],0,0,0);
    #undef PK
  }
}

#ifndef ATTN_STORE16
#define ATTN_STORE16(p,v) (*(u32x4*)(p)=(v))
#endif
template<int THRL> __device__ __forceinline__ void attn_unit(int b,int h,int qb,const f16*Q,const f16*__restrict__ K,const f16*__restrict__ V,f16*O,const unsigned*__restrict__ SEL,char*shm){
  const int tid=threadIdx.x,lane=tid&63,r32=lane&31,hi=lane>>5; const int wid=__builtin_amdgcn_readfirstlane(tid>>6);
  const long rowbase=(long)b*SEQ; const int q0=qb*QB;
  const f16*Qw=Q+(rowbase+q0+wid*QBLK)*DM+h*D;
  const f16*Kh=K+rowbase*DM+h*D,*Vh=V+rowbase*DM+h*D;
  const unsigned lds0=(unsigned)(uintptr_t)shm;
  float*wsf=(float*)(shm+LDS_WS)+wid*64;
  const f16*ksrc=Kh+(long)lane*DM+wid*8;
  const f16*vsrc=Vh+(long)(16*(wid&3)+(lane>>2))*DM+(wid>>2)*32+(lane&3)*8;
  const unsigned kdst=lds0+LDS_K+wid*1024, vdst=lds0+LDS_V+wid*1024;
  #define TILE(t) (((t)==0)?(NT-4):(((t)<=NT-4)?((t)-1):(t)))
  #define DMA_K(t,slot) glds16(ksrc+(long)TILE(t)*KVBLK*DM,(unsigned)__builtin_amdgcn_readfirstlane(kdst+(slot)))
  #define DMA_V(t,slot) glds16(vsrc+(long)TILE(t)*KVBLK*DM,(unsigned)__builtin_amdgcn_readfirstlane(vdst+(slot)))
  const int vb0=(int)(lds0+LDS_V)+((lane>>4)&1)*32+(lane&3)*8+(4*hi+((lane&15)>>2))*64;
  const char*Kbase=shm+LDS_K; h16x8 kf[8];
  const lds_cptr shm3=(lds_cptr)shm; const lds_cptr kp0=shm3+LDS_K+hi*1024+r32*16; const lds_cptr vp0=shm3+LDS_V+((lane>>4)&1)*32+(lane&3)*8+(4*hi+((lane&15)>>2))*64;
  const int NT=(q0+QB)/KVBLK;
  DMA_K(0,0);DMA_V(0,0);DMA_K(1,SLOTB);
  h16x8 qr[4];
  #pragma unroll
  for(int d0=0;d0<4;++d0)qr[d0]=*reinterpret_cast<const h16x8*>(&Qw[(long)r32*DM+d0*16+hi*8]);
  float mhat=0.f,l_reg=0.f;f32x16 o[2];o[0]=f32x16{};o[1]=f32x16{};f32x16 negm=f32x16{};asm volatile("":"+v"(negm));
  const int qrel=wid*QBLK+r32;
  const unsigned selmask=SEL[(rowbase+q0+qrel)*NHEAD+h];
  #define NEGM_SET(tn) do{ const bool nx_=((tn)>=NT-3)||(((selmask>>((((tn)-1)>>2)&15))&1u)!=0u); const float nv_=nx_?-mhat:-INFINITY; _Pragma("unroll") for(int r=0;r<16;++r)negm[r]=nv_; asm volatile("":"+v"(negm)); }while(0)
  #define CMASK(P0,P1,t) do{int jb_=(t)-(NT-4); if(jb_>=1)cmask(P0,P1,jb_,qrel,hi);}while(0)
  bool resc=false;
  #define START(P0,P1) do{ const float rm=rowmax(P0,P1); resc=false; \
    { const float dl=rm; mhat=fadd_s(mhat,dl); \
      _Pragma("unroll") for(int r=0;r<16;++r){P0[r]=fsub_s(P0[r],dl);P1[r]=fsub_s(P1[r],dl);} \
      NEGM_SET(1); } \
    _Pragma("unroll") for(int r=0;r<16;++r)P0[r]=__builtin_amdgcn_exp2f(P0[r]); }while(0)
  #define RESC() do{ if(resc){ asm volatile("s_waitcnt lgkmcnt(0)":::"memory"); \
      _Pragma("unroll") for(int d_=0;d_<2;++d_) _Pragma("unroll") for(int r=0;r<16;++r)o[d_][r]*=wsf[crow(r,hi)]; } }while(0)
  f32x16 pA0,pA1,pB0,pB1;
  int sl_prev=0,sl_cur=0,sl_next=SLOTB;
  #define ROT() do{sl_prev=sl_cur;sl_cur=sl_next;sl_next=(sl_next==(NSLOT-1)*SLOTB)?0:sl_next+SLOTB;}while(0)
  DMA_K(2,2*SLOTB);
  WAIT_BAR(3);
  qkt(pA0,pA1,Kbase,qr,negm,r32,hi);asm volatile("s_nop 15\n\ts_nop 7":"+v"(pA0),"+v"(pA1));cmask(pA0,pA1,0,qrel,hi);
  START(pA0,pA1);
  _Pragma("unroll") for(int r=0;r<16;++r)pA1[r]=__builtin_amdgcn_exp2f(pA1[r]);
  WAIT_BAR(0);
  DMA_K(3,0);DMA_V(1,SLOTB);
  ROT();
  kload8(kf,kp0+sl_cur);
  WAIT_BAR(2);
  s16x4 vlo[8],vhi[8]; u32x4 pw0,pw1,pw2,pw3;
  #define PKW(P,B) cvtpk_s(P[B],P[B+1])
  #define PAF(k) __builtin_bit_cast(h16x8,pw##k)
  #define VFR(i) __builtin_bit_cast(h16x8,(s16x8){vlo[i][0],vlo[i][1],vlo[i][2],vlo[i][3],vhi[i][0],vhi[i][1],vhi[i][2],vhi[i][3]})
  #define PIN(x) asm volatile("":"+v"(x))
  #define MX3(a,b,c) __builtin_fmaxf(__builtin_fmaxf((a),(b)),(c))
  #define GAPA(MF,A0,A1,A2,A3,W0,W1,PW) do{ MF; sacc+=A0; sacc+=A1; sacc+=A2; sacc+=A3; PIN(sacc); W0; W1; PIN(PW); SBAR(); }while(0)
  #define EX(v) __builtin_amdgcn_exp2f(v)
  #define GAPB(MF,X,B) do{ MF; X[B]=EX(X[B]); X[B+1]=EX(X[B+1]); X[B+2]=EX(X[B+2]); X[B+3]=EX(X[B+3]); PIN(X); SBAR(); }while(0)
  #define VRD(i) do{ vlo[i]=vtr(vp_+(((i)>>2)*4096+((i)&3)*1024)); vhi[i]=vtr(vp_+(((i)>>2)*4096+((i)&3)*1024+512)); }while(0)
  #define KRD(G,j) do{ if(G){ kload2(kf,kp0+sl_next,j); SBAR(); } }while(0)
  #define STEP(C0,C1,P0,P1,t,GK,GV,GL) do{ SBAR(); \
    const lds_cptr vp_=vp0+sl_prev; \
    VRD(0); SBAR(); float sacc=(P0[0]+P0[1]); \
    GAPA(C0=__builtin_amdgcn_mfma_f32_32x32x16_f16(kf[0],qr[0],negm,0,0,0), P0[2],P0[3],P0[4],P0[5],     pw0[0]=PKW(P0,0), pw0[1]=PKW(P0,2), pw0); \
    VRD(4); SBAR(); GAPA(C1=__builtin_amdgcn_mfma_f32_32x32x16_f16(kf[1],qr[0],negm,0,0,0), P0[6],P0[7],P0[8],P0[9],     pw0[2]=PKW(P0,4), pw0[3]=PKW(P0,6), pw0); \
    VRD(1); SBAR(); GAPA(C0=__builtin_amdgcn_mfma_f32_32x32x16_f16(kf[2],qr[1],C0,0,0,0),   P0[10],P0[11],P0[12],P0[13], pw1[0]=PKW(P0,8), pw1[1]=PKW(P0,10), pw1); \
    VRD(5); SBAR(); GAPA(C1=__builtin_amdgcn_mfma_f32_32x32x16_f16(kf[3],qr[1],C1,0,0,0),   P0[14],P0[15],P1[0],P1[1],   pw1[2]=PKW(P0,12),pw1[3]=PKW(P0,14), pw1); \
    VRD(2); SBAR(); GAPA(C0=__builtin_amdgcn_mfma_f32_32x32x16_f16(kf[4],qr[2],C0,0,0,0),   P1[2],P1[3],P1[4],P1[5],     pw2[0]=PKW(P1,0), pw2[1]=PKW(P1,2), pw2); \
    VRD(6); SBAR(); GAPA(C1=__builtin_amdgcn_mfma_f32_32x32x16_f16(kf[5],qr[2],C1,0,0,0),   P1[6],P1[7],P1[8],P1[9],     pw2[2]=PKW(P1,4), pw2[3]=PKW(P1,6), pw2); \
    VRD(3); SBAR(); GAPA(C0=__builtin_amdgcn_mfma_f32_32x32x16_f16(kf[6],qr[3],C0,0,0,0),   P1[10],P1[11],P1[12],P1[13], pw3[0]=PKW(P1,8), pw3[1]=PKW(P1,10), pw3); \
    VRD(7); SBAR(); GAPA(C1=__builtin_amdgcn_mfma_f32_32x32x16_f16(kf[7],qr[3],C1,0,0,0),   P1[14],P1[15],0.f,0.f,       pw3[2]=PKW(P1,12),pw3[3]=PKW(P1,14), pw3); \
    l_reg+=sacc; \
    if(GK){DMA_K((t)+3,sl_cur);} if(GV){DMA_V((t)+1,sl_next);} \
    CMASK(C0,C1,t); \
    { float a=MX3(C0[0],C0[1],C1[0]),b=MX3(C0[2],C0[3],C1[1]); a=MX3(a,C1[2],C1[3]); \
      _Pragma("unroll") for(int r=4;r<16;r+=4){a=MX3(a,C0[r],C0[r+1]);b=MX3(b,C0[r+2],C0[r+3]);a=MX3(a,C1[r],C1[r+1]);b=MX3(b,C1[r+2],C1[r+3]);} \
      float rm=__builtin_fmaxf(a,b); { auto rr=__builtin_amdgcn_permlane32_swap(__float_as_uint(rm),__float_as_uint(rm),false,false); rm=__builtin_fmaxf(__uint_as_float(rr[0]),__uint_as_float(rr[1])); } \
      resc=false; \
      if(__builtin_expect(__any(rm>(float)THRL),0)){ const float dl=__builtin_fmaxf(rm,0.f); mhat+=dl; \
        _Pragma("unroll") for(int r=0;r<16;++r){C0[r]-=dl;C1[r]-=dl;} \
        const float f=__builtin_amdgcn_exp2f(-dl); l_reg*=f; if(hi==0)wsf[r32]=f; resc=true; } \
      if(resc||(((t)&3)==0)||((t)+4>=NT)){ NEGM_SET((t)+1); } } \
    SBAR(); \
    GAPB(o[0]=__builtin_amdgcn_mfma_f32_32x32x16_f16(PAF(0),VFR(0),o[0],0,0,0), C0,0); \
    GAPB(o[1]=__builtin_amdgcn_mfma_f32_32x32x16_f16(PAF(0),VFR(4),o[1],0,0,0), C0,4); \
    KRD(GL,0); GAPB(o[0]=__builtin_amdgcn_mfma_f32_32x32x16_f16(PAF(1),VFR(1),o[0],0,0,0), C0,8); \
    KRD(GL,1); GAPB(o[1]=__builtin_amdgcn_mfma_f32_32x32x16_f16(PAF(1),VFR(5),o[1],0,0,0), C0,12); \
    KRD(GL,2); GAPB(o[0]=__builtin_amdgcn_mfma_f32_32x32x16_f16(PAF(2),VFR(2),o[0],0,0,0), C1,0); \
    KRD(GL,3); GAPB(o[1]=__builtin_amdgcn_mfma_f32_32x32x16_f16(PAF(2),VFR(6),o[1],0,0,0), C1,4); \
    GAPB(o[0]=__builtin_amdgcn_mfma_f32_32x32x16_f16(PAF(3),VFR(3),o[0],0,0,0), C1,8); \
    GAPB(o[1]=__builtin_amdgcn_mfma_f32_32x32x16_f16(PAF(3),VFR(7),o[1],0,0,0), C1,12); \
    }while(0)
  int t=1;
  #undef CMASK
  #define CMASK(P0,P1,t) do{}while(0)
  for(;t+5<NT;t+=2){
    STEP(pB0,pB1,pA0,pA1,t,true,true,true);     WAIT_BAR(2); RESC(); ROT();
    STEP(pA0,pA1,pB0,pB1,t+1,true,true,true);   WAIT_BAR(2); RESC(); ROT();
  }
  #undef CMASK
  #define CMASK(P0,P1,t) do{int jb_=(t)-(NT-4); if(jb_>=1)cmask(P0,P1,jb_,qrel,hi);}while(0)
  #define ENDW(tt) do{ if((tt)+3<NT){WAIT_BAR(2);} else if((tt)+2<NT){WAIT_BAR(1);} else {WAIT_BAR(0);} }while(0)
  for(;t+1<NT;t+=2){
    STEP(pB0,pB1,pA0,pA1,t,(t+3<NT),(t+1<NT),(t+1<NT));       ENDW(t);   RESC(); ROT();
    STEP(pA0,pA1,pB0,pB1,t+1,(t+4<NT),(t+2<NT),(t+2<NT));     ENDW(t+1); RESC(); ROT();
  }
  STEP(pB0,pB1,pA0,pA1,NT-1,false,false,false); RESC();
  { float sacc=pB0[0]+pB0[1]; _Pragma("unroll") for(int r=2;r<16;++r)sacc+=pB0[r]; _Pragma("unroll") for(int r=0;r<16;++r)sacc+=pB1[r]; l_reg+=sacc;
    pw0=(u32x4){PKW(pB0,0),PKW(pB0,2),PKW(pB0,4),PKW(pB0,6)};pw1=(u32x4){PKW(pB0,8),PKW(pB0,10),PKW(pB0,12),PKW(pB0,14)};pw2=(u32x4){PKW(pB1,0),PKW(pB1,2),PKW(pB1,4),PKW(pB1,6)};pw3=(u32x4){PKW(pB1,8),PKW(pB1,10),PKW(pB1,12),PKW(pB1,14)};
    SBAR(); pv(o,vb0+sl_cur,PAF(0),PAF(1),PAF(2),PAF(3)); }
  #undef PKW
  #undef PAF
  #undef VFR
  #undef PIN
  #undef MX3
  #undef GAPA
  #undef GAPB
  #undef EX
  #undef VRD
  #undef KRD
  #undef STEP
  #undef ENDW
  {auto rr=__builtin_amdgcn_permlane32_swap(__float_as_uint(l_reg),__float_as_uint(l_reg),false,false);l_reg=__uint_as_float(rr[0])+__uint_as_float(rr[1]);}
  if(hi==0)wsf[32+r32]=l_reg;asm volatile("s_waitcnt lgkmcnt(0)":::"memory");
  float rli[16];
  #pragma unroll
  for(int r=0;r<16;++r)rli[r]=__builtin_amdgcn_rcpf(wsf[32+crow(r,hi)]);
  f16*Ow=O+(rowbase+q0+wid*QBLK)*DM+h*D;
  { f16*stg=(f16*)(shm+LDS_OST)+wid*2048;
    #pragma unroll
    for(int r=0;r<16;++r){const int orow=crow(r,hi);
      #pragma unroll
      for(int d0=0;d0<2;++d0)stg[orow*64+d0*32+r32]=(f16)(o[d0][r]*rli[r]);}
    asm volatile("s_waitcnt lgkmcnt(0)":::"memory");
    #pragma unroll
    for(int i=0;i<4;++i){const int row=i*8+(lane>>3),ch=lane&7; const u32x4 v=*(const u32x4*)(stg+row*64+ch*8); ATTN_STORE16(Ow+(long)row*DM+ch*8,v);} }
  asm volatile("s_waitcnt lgkmcnt(0)\n\ts_barrier":::"memory");
  #undef DMA_K
  #undef TILE
  #undef NEGM_SET
  #undef DMA_V
  #undef CMASK
  #undef START
  #undef RESC
  #undef ROT
}
constexpr int ATTN_LDS_BYTES=LDS_BYTES;
struct AttnTensors { const f16* Q; const f16* K; const f16* V; f16* O; const unsigned* SEL; };
struct AttnUnit { int bh; int qb; };
struct StaticOrder {
  int vcu;
  __device__ __forceinline__ explicit StaticOrder(int grid,int block):vcu((block%8)*(grid/8)+block/8){}
  __device__ __forceinline__ bool next(int i,AttnUnit&u)const{ if(i>=4)return false; const int s=vcu&3; u.bh=vcu>>2; u.qb=(i==0)?15-s:(i==1)?8+s:(i==2)?7-s:s; return true; }
  __device__ __forceinline__ void a_ready(const AttnUnit&)const{}
  __device__ __forceinline__ void done(const AttnUnit&)const{}
};
template<class Sched,int THRL=8> __device__ __forceinline__ void attn_phase(char*lds,const AttnTensors&T,const Sched&S){
  AttnUnit u;
  for(int i=0;S.next(i,u);++i){ S.a_ready(u); attn_unit<THRL>(u.bh/NHEAD,u.bh%NHEAD,u.qb,T.Q,T.K,T.V,T.O,T.SEL,lds); S.done(u); }
}
#undef SBAR
#undef WAIT_BAR
}
#define XB_TMO      128
#define XB_XCNT(j)  (256  + 64 * (j))
#define XB_XSUB(j)  (1280 + 64 * (j))
#define XB_XGEN(j)  (2304 + 64 * (j))
#define XB_TOP      3328
#define XB_TOPGEN   3392
#define XCD_BAR_WORDS 3456
#define XB_SPIN_CAP (1u << 18)

__device__ __forceinline__ unsigned xb_ld(unsigned* p)              { return __hip_atomic_load(p, __ATOMIC_RELAXED, __HIP_MEMORY_SCOPE_AGENT); }
__device__ __forceinline__ unsigned xb_add(unsigned* p, unsigned v) { return __hip_atomic_fetch_add(p, v, __ATOMIC_RELAXED, __HIP_MEMORY_SCOPE_AGENT); }
__device__ __forceinline__ unsigned xb_xcc_id() { return (unsigned)__builtin_amdgcn_s_getreg((3 << 11) | 20) & 0xFu; }
#define XB_SPIN(cond, bar) do { unsigned _sp = 0; while (cond) { __builtin_amdgcn_s_sleep(1); \
    if ((++_sp & 255u) == 0u) { if (xb_ld(&(bar)[XB_TMO])) break; if (_sp > XB_SPIN_CAP) { atomicAdd(&(bar)[XB_TMO], 1u); break; } } } } while (0)

struct XcdBarrier {
    unsigned* bar; unsigned x;
    volatile LAS unsigned* st;
};

__device__ __forceinline__ XcdBarrier xcd_barrier_post(unsigned* bar, volatile LAS unsigned* st) {
    XcdBarrier b; b.bar = bar; b.x = xb_xcc_id(); b.st = st;
    if (threadIdx.x == 0) (void)xb_add(&bar[XB_XCNT(b.x)], 1u);
    return b;
}
__device__ __forceinline__ void xcd_barrier_complete(unsigned* bar, unsigned x, unsigned& nloc, unsigned& nx) {
    const unsigned G = gridDim.x * gridDim.y * gridDim.z;
    unsigned sum, cnt, mine, sp = 0u;
    for (;;) {
        sum = 0u; cnt = 0u; mine = 0u;
#pragma unroll
        for (unsigned j = 0; j < 16; ++j) { const unsigned c = xb_ld(&bar[XB_XCNT(j)]); sum += c; cnt += (c > 0u) ? 1u : 0u; mine = (j == x) ? c : mine; }
        if (sum == G) break;
        __builtin_amdgcn_s_sleep(1);
        if ((++sp & 255u) == 0u) { if (xb_ld(&bar[XB_TMO])) break; if (sp > XB_SPIN_CAP) { atomicAdd(&bar[XB_TMO], 1u); break; } }
    }
    nloc = mine > 0u ? mine : 1u; nx = cnt > 0u ? cnt : 1u;
}

__device__ __forceinline__ void xcd_barrier(const XcdBarrier& b) {
    asm volatile("s_waitcnt vmcnt(0)" ::: "memory");
    __syncthreads();
    if (threadIdx.x == 0) {
        unsigned* bar = b.bar;
        __builtin_amdgcn_s_waitcnt(0);
        unsigned nloc = b.st[0], nx = b.st[1];
        if (nloc == 0u) { xcd_barrier_complete(bar, b.x, nloc, nx); b.st[0] = nloc; b.st[1] = nx; }
        const unsigned old = xb_add(&bar[XB_XSUB(b.x)], 1u);
        const unsigned gen = old / nloc;
        if (old + 1u == (gen + 1u) * nloc) {
            __builtin_amdgcn_fence(__ATOMIC_RELEASE, "agent");
            asm volatile("s_waitcnt vmcnt(0)" ::: "memory");
            const unsigned og = xb_add(&bar[XB_TOP], 1u);
            const unsigned tg = og / nx;
            if (og + 1u == (tg + 1u) * nx) xb_add(&bar[XB_TOPGEN], 1u);
            else XB_SPIN(xb_ld(&bar[XB_TOPGEN]) == tg, bar);
            __builtin_amdgcn_fence(__ATOMIC_ACQUIRE, "agent");
            xb_add(&bar[XB_XGEN(b.x)], 1u);
            asm volatile("s_waitcnt vmcnt(0)" ::: "memory");
        } else {
            XB_SPIN(xb_ld(&bar[XB_XGEN(b.x)]) == gen, bar);
            __builtin_amdgcn_fence(__ATOMIC_ACQUIRE, "agent");
            asm volatile("s_waitcnt vmcnt(0)" ::: "memory");
        }
    }
    __syncthreads();
}

struct Args {
    const float* x; const float* c; const float* w_ada; const float* b_ada; const float* g_pre_mix; const float* w_in; const float* w_pool; const float* pool_scale;
    const float* attn_out_gain; const float* pool_out_gain; const float* w_out; const float* g_post_mix; const float* g_pre_ffn; const float* w_up; const float* conv_w;
    const float* conv_b; const float* w_down; const float* g_post_ffn;
    float* out; unsigned char* ws;
    int ph_lo, ph_hi, li, chunk;
};

constexpr int ARGS_OFF = LDSCTL_OFF + 1024;
__device__ __forceinline__ const void* lds_ptr(LAS unsigned char* lds, int i) { const unsigned long long v = ((const LAS unsigned long long*)(lds + ARGS_OFF))[i];
    const unsigned lo = __builtin_amdgcn_readfirstlane((unsigned)v), hi = __builtin_amdgcn_readfirstlane((unsigned)(v >> 32)); return (const void*)(((unsigned long long)hi << 32) | lo); }
__device__ __forceinline__ Args lds_args(LAS unsigned char* lds) { Args a{};
    a.x = (const float*)lds_ptr(lds, 0); a.c = (const float*)lds_ptr(lds, 1); a.w_ada = (const float*)lds_ptr(lds, 2); a.b_ada = (const float*)lds_ptr(lds, 3); a.g_pre_mix = (const float*)lds_ptr(lds, 4);
    a.w_in = (const float*)lds_ptr(lds, 5); a.w_pool = (const float*)lds_ptr(lds, 6); a.pool_scale = (const float*)lds_ptr(lds, 7); a.attn_out_gain = (const float*)lds_ptr(lds, 8); a.pool_out_gain = (const float*)lds_ptr(lds, 9);
    a.w_out = (const float*)lds_ptr(lds, 10); a.g_post_mix = (const float*)lds_ptr(lds, 11); a.g_pre_ffn = (const float*)lds_ptr(lds, 12); a.w_up = (const float*)lds_ptr(lds, 13); a.conv_w = (const float*)lds_ptr(lds, 14);
    a.conv_b = (const float*)lds_ptr(lds, 15); a.w_down = (const float*)lds_ptr(lds, 16); a.g_post_ffn = (const float*)lds_ptr(lds, 17); a.out = (float*)lds_ptr(lds, 18); a.ws = (unsigned char*)lds_ptr(lds, 19);
    return a; }

constexpr int PH_PRO = 0, PH_PRE = 1, PH_L0 = 2;
constexpr int J_G1 = 0;
constexpr int J_ROPE = OPT_INPROJ ? -1 : 1;
constexpr int J_GATE = OPT_INPROJ ? 1 : 2;
constexpr int J_ATT = J_GATE + 1;
constexpr int J_MERGE = J_ATT + 1, J_G2 = J_ATT + 2, J_POST1 = J_ATT + 3, J_G3 = J_ATT + 4, J_FIX = J_ATT + 5, J_G4 = J_ATT + 6, J_POST2 = J_ATT + 7, NPL = J_ATT + 8;
constexpr int NPH = PH_L0 + DEPTH * NPL;

__device__ __forceinline__ void transpose_item(const float* W, int K, int N, f16_t* WT, int k0, int n0, int drow0, LAS float* scr, int lane) {
    float wv[32];
#pragma unroll
    for (int i = 0; i < 32; ++i) { const int kk = 2 * i + (lane >> 5); wv[i] = W[(size_t)(k0 + kk) * N + n0 + (lane & 31)]; }
#pragma unroll
    for (int i = 0; i < 32; ++i) { const int kk = 2 * i + (lane >> 5); scr[kk * 33 + (lane & 31)] = wv[i]; }
    LDS_WAIT(); asm volatile("" ::: "memory");
    const int c = lane & 7;
#pragma unroll
    for (int j = 0; j < 4; ++j) { const int n = (lane >> 3) + 8 * j; const LAS float* s = scr + (8 * c) * 33 + n;
        v4u o; o.x = pkh(s[0 * 33], s[1 * 33]); o.y = pkh(s[2 * 33], s[3 * 33]); o.z = pkh(s[4 * 33], s[5 * 33]); o.w = pkh(s[6 * 33], s[7 * 33]);
        *(v4u*)(WT + (size_t)(drow0 + n) * K + k0 + 8 * c) = o; }
    LDS_WAIT(); asm volatile("" ::: "memory");
}
__device__ __forceinline__ int up_row(int n) {
#if OPT_FFN
    const int bj = n / FF, rem = n - bj * FF; return 256 * (rem >> 7) + 128 * bj + (rem & 127);
#else
    return n;
#endif
}
constexpr int NIN_COLS = OPT_POOL ? 1536 : 2048;
constexpr int IT_IN = 16 * (NIN_COLS / 32), IT_OUT = 16 * 32, IT_UP = 16 * (FF2 / 32), IT_DOWN = (FF / 64) * 32, IT_LAYER = IT_IN + IT_OUT + IT_UP + IT_DOWN;

__device__ __forceinline__ void ph_prologue(const Args& a, LAS unsigned char* lds, int tid, int lane, int wave, int vcu, int G) {
    unsigned char* ws = a.ws;
    if (vcu < 48) {
        const int l = vcu / 24, jc = vcu % 24;
        LAS float* cact = (LAS float*)lds;
        LAS float* part = (LAS float*)(lds + 32768);
        for (int i = tid; i < 8192; i += 512) { const int b = i >> 10, k = i & 1023; const float v = a.c[i]; cact[k * 8 + b] = silu_f(v); }
        __syncthreads();
        f32x4 acc[8];
#pragma unroll
        for (int b = 0; b < 8; ++b) acc[b] = (f32x4){0.f, 0.f, 0.f, 0.f};
        const float* wp = a.w_ada + ((size_t)l * 1024 + wave * 128) * 6144 + jc * 256 + lane * 4;
#pragma unroll 16
        for (int k = 0; k < 128; ++k) { const f32x4 w4 = *(const f32x4*)(wp + (size_t)k * 6144);
            const f32x4 c0 = *(const LAS f32x4*)(cact + (wave * 128 + k) * 8), c1 = *(const LAS f32x4*)(cact + (wave * 128 + k) * 8 + 4);
            acc[0] += c0.x * w4; acc[1] += c0.y * w4; acc[2] += c0.z * w4; acc[3] += c0.w * w4; acc[4] += c1.x * w4; acc[5] += c1.y * w4; acc[6] += c1.z * w4; acc[7] += c1.w * w4; }
#pragma unroll
        for (int b = 0; b < 8; ++b) *(LAS f32x4*)(part + (wave * 8 + b) * 256 + lane * 4) = acc[b];
        __syncthreads();
        float* MOD = (float*)(ws + WS_MOD);
        for (int i = tid; i < 2048; i += 512) { const int b = i >> 8, col = i & 255; float s = a.b_ada[l * 6144 + jc * 256 + col];
#pragma unroll
            for (int w = 0; w < 8; ++w) s += part[(w * 8 + b) * 256 + col];
            MOD[(size_t)(l * 8 + b) * 6144 + jc * 256 + col] = s; }
        __syncthreads();
    }
    {
        LAS float* scr = (LAS float*)(lds + wave * 16384);
        const int gw = vcu * NWAVES + wave, NGW = G * NWAVES;
        for (int it = gw; it < DEPTH * IT_LAYER; it += NGW) {
            const int l = it / IT_LAYER; int r = it - l * IT_LAYER;
            unsigned char* wl = ws + WS_W + (size_t)l * W_LAYER;
            if (r < IT_IN) { const int nblk = NIN_COLS / 32, kb = r / nblk, nb = r % nblk; transpose_item(a.w_in + (size_t)l * DM * INW, DM, INW, (f16_t*)(wl + W_IN), 64 * kb, 32 * nb, 32 * nb, scr, lane); continue; } r -= IT_IN;
            if (r < IT_OUT) { const int kb = r / 32, nb = r % 32; transpose_item(a.w_out + (size_t)l * DM * DM, DM, DM, (f16_t*)(wl + W_OUT), 64 * kb, 32 * nb, 32 * nb, scr, lane); continue; } r -= IT_OUT;
            if (r < IT_UP) { const int nblk = FF2 / 32, kb = r / nblk, nb = r % nblk; transpose_item(a.w_up + (size_t)l * DM * FF2, DM, FF2, (f16_t*)(wl + W_UP), 64 * kb, 32 * nb, up_row(32 * nb), scr, lane); continue; } r -= IT_UP;
            { const int kb = r / 32, nb = r % 32; transpose_item(a.w_down + (size_t)l * FF * DM, FF, DM, (f16_t*)(wl + W_DOWN), 64 * kb, 32 * nb, 32 * nb, scr, lane); }
        }
    }
    {
        float* ROPE = (float*)(ws + WS_ROPE);
        for (int i = vcu * 512 + tid; i < SEQ * 8; i += G * 512) { const int pos = i >> 3, j = i & 7;
            const float invf = j == 0 ? 1.0f : j == 1 ? 0.19392274474868576f : j == 2 ? 0.03760603093086393f : j == 3 ? 0.007292664737217109f : j == 4 ? 0.001414213562373095f :
                               j == 5 ? 0.0002742481756762073f : j == 6 ? 5.318295896944988e-05f : 1.031338537721246e-05f;
            const float ang = (float)pos * invf; const double rev = (double)ang * 0.15915494309189535; const float fr = (float)(rev - __builtin_floor(rev));
            ROPE[pos * 16 + j] = __builtin_amdgcn_cosf(fr); ROPE[pos * 16 + 8 + j] = __builtin_amdgcn_sinf(fr); }
    }
#if OPT_POOL
    if (vcu >= 128) {
        __syncthreads();
        const int item = vcu - 128, l = item >> 6, g = (item >> 4) & 3, kb = item & 15;
        LAS float* wpl = (LAS float*)lds;
        LAS float* wit = (LAS float*)(lds + 65536);
        const float* wps = a.w_pool + (size_t)(l * 4 + g) * 128 * 128;
        for (int i = tid; i < 128 * 128 / 4; i += 512) *(LAS f32x4*)(wpl + 4 * i) = *(const f32x4*)(wps + 4 * i);
        const float* wis = a.w_in + (size_t)l * DM * INW + (size_t)(64 * kb) * INW + 1536 + 128 * g;
        for (int i = tid; i < 64 * 128; i += 512) { const int k = i >> 7, cc = i & 127; wit[k * 129 + cc] = wis[(size_t)k * INW + cc]; }
        __syncthreads();
        const int k = tid & 63, e0 = (tid >> 6) * 16;
        float accp[16];
#pragma unroll
        for (int e = 0; e < 16; ++e) accp[e] = 0.f;
        for (int cc = 0; cc < 128; ++cc) { const float wv = wit[k * 129 + cc];
#pragma unroll
            for (int e4 = 0; e4 < 4; ++e4) { const f32x4 p4 = *(const LAS f32x4*)(wpl + cc * 128 + e0 + 4 * e4); accp[4 * e4 + 0] += wv * p4.x; accp[4 * e4 + 1] += wv * p4.y; accp[4 * e4 + 2] += wv * p4.z; accp[4 * e4 + 3] += wv * p4.w; } }
        f16_t* WT = (f16_t*)(ws + WS_W + (size_t)l * W_LAYER + W_IN);
#pragma unroll
        for (int e = 0; e < 16; ++e) { const float ps = a.pool_scale[l * PW + 128 * g + e0 + e]; WT[(size_t)(1536 + 128 * g + e0 + e) * DM + 64 * kb + k] = f2h(accp[e] * ps); }
        __syncthreads();
    }
#endif
}

__device__ __forceinline__ void ph_pre(const float* x, const float* g, const float* sc, const float* sh, f16_t* H, int row0, int lane) {
    f32x4 gm[4], sh4[4];
#pragma unroll
    for (int j = 0; j < 4; ++j) { const f32x4 g4 = *(const f32x4*)(g + 256 * j + 4 * lane), s4 = *(const f32x4*)(sc + 256 * j + 4 * lane); gm[j] = g4 * (1.0f + s4); sh4[j] = *(const f32x4*)(sh + 256 * j + 4 * lane); }
    f32x4 v[4];
#pragma unroll
    for (int j = 0; j < 4; ++j) v[j] = *(const f32x4*)(x + (size_t)row0 * DM + 256 * j + 4 * lane);
    for (int r = 0; r < 16; ++r) { const size_t row = (size_t)(row0 + r);
        f32x4 vn[4];
#pragma unroll
        for (int j = 0; j < 4; ++j) vn[j] = v[j];
        if (r + 1 < 16) {
#pragma unroll
            for (int j = 0; j < 4; ++j) vn[j] = *(const f32x4*)(x + (row + 1) * DM + 256 * j + 4 * lane);
        }
        float ss = 0.f;
#pragma unroll
        for (int j = 0; j < 4; ++j) ss += (v[j].x * v[j].x + v[j].y * v[j].y) + (v[j].z * v[j].z + v[j].w * v[j].w);
        const float rstd = rsq(wave_sum(ss) * (1.0f / DM) + NORM_EPS);
#pragma unroll
        for (int j = 0; j < 4; ++j) { const f32x4 o = v[j] * rstd * gm[j] + sh4[j]; v2u w; w.x = pkh(o.x, o.y); w.y = pkh(o.z, o.w); *(v2u*)(H + row * DM + 256 * j + 4 * lane) = w; }
#pragma unroll
        for (int j = 0; j < 4; ++j) v[j] = vn[j];
    }
}
template <bool XIN16, bool XOUT16>
__device__ __forceinline__ void ph_post(const f16_t* Y, const void* xin_, void* xout_, const float* gpost, const float* gt, bool has_next, const float* gn, const float* scn, const float* shn, f16_t* H, int row0, int lane) {
    f32x4 gg[4], gm[4], sh4[4];
#pragma unroll
    for (int j = 0; j < 4; ++j) { gg[j] = *(const f32x4*)(gpost + 256 * j + 4 * lane) * *(const f32x4*)(gt + 256 * j + 4 * lane); gm[j] = (f32x4){0.f, 0.f, 0.f, 0.f}; sh4[j] = gm[j]; }
    if (has_next) {
#pragma unroll
        for (int j = 0; j < 4; ++j) { const f32x4 g4 = *(const f32x4*)(gn + 256 * j + 4 * lane), s4 = *(const f32x4*)(scn + 256 * j + 4 * lane); gm[j] = g4 * (1.0f + s4); sh4[j] = *(const f32x4*)(shn + 256 * j + 4 * lane); }
    }
    const float* xin32 = (const float*)xin_; const f16_t* xin16 = (const f16_t*)xin_; float* xout32 = (float*)xout_; f16_t* xout16 = (f16_t*)xout_;
    auto ldx = [&](size_t row, int j) -> f32x4 { if (XIN16) { const v2u w = *(const v2u*)(xin16 + row * DM + 256 * j + 4 * lane); const f32x2 a0 = unpk(w.x), a1 = unpk(w.y); return (f32x4){a0.x, a0.y, a1.x, a1.y}; }
                                                  else return *(const f32x4*)(xin32 + row * DM + 256 * j + 4 * lane); };
    v2u yw[4]; f32x4 xv[4];
#pragma unroll
    for (int j = 0; j < 4; ++j) { yw[j] = *(const v2u*)(Y + (size_t)row0 * DM + 256 * j + 4 * lane); xv[j] = ldx((size_t)row0, j); }
    for (int r = 0; r < 16; ++r) { const size_t row = (size_t)(row0 + r);
        v2u ywn[4]; f32x4 xvn[4];
#pragma unroll
        for (int j = 0; j < 4; ++j) { ywn[j] = yw[j]; xvn[j] = xv[j]; }
        if (r + 1 < 16) {
#pragma unroll
            for (int j = 0; j < 4; ++j) { ywn[j] = *(const v2u*)(Y + (row + 1) * DM + 256 * j + 4 * lane); xvn[j] = ldx(row + 1, j); }
        }
        f32x4 y[4]; float ss = 0.f;
#pragma unroll
        for (int j = 0; j < 4; ++j) { const f32x2 a0 = unpk(yw[j].x), a1 = unpk(yw[j].y); y[j] = (f32x4){a0.x, a0.y, a1.x, a1.y}; ss += (y[j].x * y[j].x + y[j].y * y[j].y) + (y[j].z * y[j].z + y[j].w * y[j].w); }
        const float rstd = rsq(wave_sum(ss) * (1.0f / DM) + NORM_EPS); float s2 = 0.f;
#pragma unroll
        for (int j = 0; j < 4; ++j) { xv[j] = xv[j] + y[j] * rstd * gg[j];
            if (XOUT16) { v2u w; w.x = pkh(xv[j].x, xv[j].y); w.y = pkh(xv[j].z, xv[j].w); *(v2u*)(xout16 + row * DM + 256 * j + 4 * lane) = w; const f32x2 a0 = unpk(w.x), a1 = unpk(w.y); xv[j] = (f32x4){a0.x, a0.y, a1.x, a1.y}; }
            else *(f32x4*)(xout32 + row * DM + 256 * j + 4 * lane) = xv[j];
            s2 += (xv[j].x * xv[j].x + xv[j].y * xv[j].y) + (xv[j].z * xv[j].z + xv[j].w * xv[j].w); }
        if (has_next) { const float r2 = rsq(wave_sum(s2) * (1.0f / DM) + NORM_EPS);
#pragma unroll
            for (int j = 0; j < 4; ++j) { const f32x4 o = xv[j] * r2 * gm[j] + sh4[j]; v2u w; w.x = pkh(o.x, o.y); w.y = pkh(o.z, o.w); *(v2u*)(H + row * DM + 256 * j + 4 * lane) = w; } }
#pragma unroll
        for (int j = 0; j < 4; ++j) { yw[j] = ywn[j]; xv[j] = xvn[j]; }
    }
}
__device__ __forceinline__ void unpk8(const v4u w, float (&v)[8]) { const f32x2 a = unpk(w.x), b = unpk(w.y), c = unpk(w.z), d = unpk(w.w); v[0] = a.x; v[1] = a.y; v[2] = b.x; v[3] = b.y; v[4] = c.x; v[5] = c.y; v[6] = d.x; v[7] = d.y; }
__device__ __forceinline__ v4u pk8(const float (&v)[8]) { v4u w; w.x = pkh(v[0], v[1]); w.y = pkh(v[2], v[3]); w.z = pkh(v[4], v[5]); w.w = pkh(v[6], v[7]); return w; }
__device__ __forceinline__ void ph_merge(const Args& a, int l, const f16_t* AO, const f16_t* R, f16_t* MG, LAS float* scr, int row0, int lane) {
    float ag[8], pg[8], psc[8];
#pragma unroll
    for (int e = 0; e < 8; ++e) { ag[e] = a.attn_out_gain[l * AW + 8 * lane + e]; pg[e] = a.pool_out_gain[l * PW + 8 * lane + e]; psc[e] = a.pool_scale[l * PW + 8 * lane + e]; }
    const int g = lane >> 4, w = 2 << g;
    float sum[8];
#pragma unroll
    for (int e = 0; e < 8; ++e) sum[e] = 0.f;
    { const int t0 = (int)(row0 & (SEQ - 1));
        for (int i = 1; i <= 16; ++i) { if (i <= w && t0 - i >= 0) { float pv[8]; unpk8(*(const v4u*)(R + (size_t)(row0 - i) * PW + 8 * lane), pv);
#pragma unroll
                for (int e = 0; e < 8; ++e) sum[e] += pv[e]; } } }
    const v4u zero4 = (v4u){0u, 0u, 0u, 0u};
    v4u aw = *(const v4u*)(AO + (size_t)row0 * AW + 8 * lane), pw = *(const v4u*)(R + (size_t)row0 * PW + 8 * lane), ow = zero4;
    if ((int)(row0 & (SEQ - 1)) - w >= 0) ow = *(const v4u*)(R + (size_t)(row0 - w) * PW + 8 * lane);
    for (int r = 0; r < 16; ++r) { const size_t row = (size_t)(row0 + r); const int tpos = (int)(row & (SEQ - 1));
        v4u awn = aw, pwn = pw, own = zero4;
        if (r + 1 < 16) { awn = *(const v4u*)(AO + (row + 1) * AW + 8 * lane); pwn = *(const v4u*)(R + (row + 1) * PW + 8 * lane);
            if (tpos + 1 - w >= 0) own = *(const v4u*)(R + (row + 1 - w) * PW + 8 * lane); }
        float av[8]; unpk8(aw, av);
        float pt[8]; unpk8(pw, pt);
        float pold[8]; unpk8(ow, pold);
        aw = awn; pw = pwn; ow = own;
        float ss = 0.f;
#pragma unroll
        for (int e = 0; e < 8; ++e) ss += av[e] * av[e];
        const float ra = rsq(wave_sum(ss) * (1.0f / AW) + NORM_EPS);
#pragma unroll
        for (int e = 0; e < 8; ++e) av[e] = av[e] * ra * ag[e];
        *(v4u*)(MG + row * DM + 8 * lane) = pk8(av);
        const int cnt = (tpos + 1) < w ? (tpos + 1) : w;
#pragma unroll
        for (int e = 0; e < 8; ++e) sum[e] += pt[e] - pold[e];
        const float ic = 1.0f / (float)cnt; float po[8];
#pragma unroll
        for (int e = 0; e < 8; ++e) po[e] = sum[e] * ic - pt[e];
#if !OPT_POOL
        *(LAS f32x4*)(scr + 8 * lane) = (f32x4){po[0], po[1], po[2], po[3]}; *(LAS f32x4*)(scr + 8 * lane + 4) = (f32x4){po[4], po[5], po[6], po[7]};
        LDS_WAIT(); asm volatile("" ::: "memory");
        float yv[8];
#pragma unroll
        for (int e = 0; e < 8; ++e) yv[e] = 0.f;
        const float* wp = a.w_pool + (size_t)(l * 4 + g) * 128 * 128 + (lane & 15) * 8;
        for (int cc = 0; cc < 128; ++cc) { const float pc = scr[g * 128 + cc]; const f32x4 w0 = *(const f32x4*)(wp + cc * 128), w1 = *(const f32x4*)(wp + cc * 128 + 4);
            yv[0] += pc * w0.x; yv[1] += pc * w0.y; yv[2] += pc * w0.z; yv[3] += pc * w0.w; yv[4] += pc * w1.x; yv[5] += pc * w1.y; yv[6] += pc * w1.z; yv[7] += pc * w1.w; }
        LDS_WAIT(); asm volatile("" ::: "memory");
#pragma unroll
        for (int e = 0; e < 8; ++e) po[e] = yv[e] * psc[e];
#endif
        float s2 = 0.f;
#pragma unroll
        for (int e = 0; e < 8; ++e) s2 += po[e] * po[e];
        const float rp = rsq(wave_sum(s2) * (1.0f / PW) + NORM_EPS);
#pragma unroll
        for (int e = 0; e < 8; ++e) po[e] = po[e] * rp * pg[e];
        *(v4u*)(MG + row * DM + AW + 8 * lane) = pk8(po);
    }
}

#if !OPT_INPROJ
__device__ __forceinline__ void ph_rope(const Args& a, LAS unsigned char* lds, int tid, int lane, int wave, int vcu) {
    f16_t* Q = (f16_t*)(a.ws + WS_Q); f16_t* K = (f16_t*)(a.ws + WS_K); const float* ROPE = (const float*)(a.ws + WS_ROPE); float* KP = (float*)(a.ws + WS_KP);
    const int row0 = vcu * 128 + wave * 16, dg = lane & 7;
    float ks[8];
#pragma unroll
    for (int e = 0; e < 8; ++e) ks[e] = 0.f;
    for (int r = 0; r < 16; ++r) { const size_t row = (size_t)(row0 + r); const int pos = (int)(row & (SEQ - 1));
        float cs[8], sn[8];
#pragma unroll
        for (int e = 0; e < 8; ++e) { cs[e] = ROPE[pos * 16 + e]; sn[e] = ROPE[pos * 16 + 8 + e]; }
#pragma unroll
        for (int t = 0; t < 2; ++t) { f16_t* T = t == 0 ? Q : K; float v[8]; unpk8(*(const v4u*)(T + row * AW + 8 * lane), v);
#pragma unroll
            for (int e = 0; e < 8; ++e) { const float pv = __shfl_xor(v[e], 1); if (dg == 0) v[e] = v[e] * cs[e] - pv * sn[e]; else if (dg == 1) v[e] = v[e] * cs[e] + pv * sn[e]; }
            if (t == 0) {
#pragma unroll
                for (int e = 0; e < 8; ++e) v[e] *= QSCALE;
            } else {
#pragma unroll
                for (int e = 0; e < 8; ++e) ks[e] += v[e];
            }
            *(v4u*)(T + row * AW + 8 * lane) = pk8(v); }
    }
    LAS float* part = (LAS float*)lds;
#pragma unroll
    for (int e = 0; e < 8; ++e) part[wave * 512 + 8 * lane + e] = ks[e];
    __syncthreads();
    { float s = 0.f;
#pragma unroll
      for (int w = 0; w < 8; ++w) s += part[w * 512 + tid];
      KP[((size_t)(vcu & 1) * 128 + (vcu >> 1)) * 512 + tid] = s; }
    __syncthreads();
}
#endif


__device__ __forceinline__ void ph_gate(unsigned char* ws, LAS unsigned char* lds, int tid, int vcu) {
    const f16_t* Q = (const f16_t*)(ws + WS_Q); const float* KP = (const float*)(ws + WS_KP); unsigned* SEL = (unsigned*)(ws + WS_SEL);
    const int rowbase = vcu * 128, b = rowbase >> 12, qb = (rowbase & (SEQ - 1)) >> 8;
    LAS float* kms = (LAS float*)lds;
    for (int i = tid; i < qb * 128; i += 512) { const int n = i >> 7, c4 = (i & 127) * 4; const float* kp = KP + ((size_t)(b * NBLK + n)) * 512 + c4;
        const f32x4 v = *(const f32x4*)kp + *(const f32x4*)(kp + 128 * 512); *(LAS f32x4*)(kms + n * 544 + (c4 >> 6) * 68 + (c4 & 63)) = v; }
    __syncthreads();
    const float NEG = -__builtin_inff();
#pragma unroll
    for (int it = 0; it < 2; ++it) { const int pair = tid + 512 * it, r = pair >> 3, h = pair & 7; const size_t row = (size_t)(rowbase + r);
        v4u qw[8];
#pragma unroll
        for (int c = 0; c < 8; ++c) qw[c] = *(const v4u*)(Q + row * AW + h * HD + 8 * c);
        float g1 = NEG, g2 = NEG, g3 = NEG; int i1 = -1, i2 = -1, i3 = -1;
        for (int n = 0; n < qb; ++n) { const LAS float* kp = kms + n * 544 + h * 68; float g = 0.f;
#pragma unroll
            for (int c = 0; c < 8; ++c) { const f32x4 k0 = *(const LAS f32x4*)(kp + 8 * c), k1 = *(const LAS f32x4*)(kp + 8 * c + 4);
                const f32x2 q0 = unpk(qw[c].x), q1 = unpk(qw[c].y), q2 = unpk(qw[c].z), q3 = unpk(qw[c].w);
                g += q0.x * k0.x; g += q0.y * k0.y; g += q1.x * k0.z; g += q1.y * k0.w; g += q2.x * k1.x; g += q2.y * k1.y; g += q3.x * k1.z; g += q3.y * k1.w; }
            if (g > g1) { g3 = g2; i3 = i2; g2 = g1; i2 = i1; g1 = g; i1 = n; } else if (g > g2) { g3 = g2; i3 = i2; g2 = g; i2 = n; } else if (g > g3) { g3 = g; i3 = n; } }
        unsigned m = 0u; if (i1 >= 0) m |= 1u << i1; if (i2 >= 0) m |= 1u << i2; if (i3 >= 0) m |= 1u << i3;
        SEL[row * NH + h] = m; }
    __syncthreads();
}

#if !OPT_ATTN
__device__ __forceinline__ void ph_attn_simple(const Args& a, LAS unsigned char* lds, int lane, int wave, int gw, int NGW) {
    const f16_t* Q = (const f16_t*)(a.ws + WS_Q); const f16_t* K = (const f16_t*)(a.ws + WS_K); const f16_t* V = (const f16_t*)(a.ws + WS_V); f16_t* AO = (f16_t*)(a.ws + WS_AO);
    const float* KP = (const float*)(a.ws + WS_KP);
    LAS float* qs = (LAS float*)(lds + wave * 8192);
    LAS float* sc = qs + 64;
    const float NEG = -__builtin_inff();
    for (int item = gw; item < M * NH; item += NGW) {
        const int row = item >> 3, h = item & 7, b = row >> 12, tpos = row & (SEQ - 1), qb = tpos >> 8;
        const float qd = h2f(Q[(size_t)row * AW + h * HD + lane]);
        qs[lane] = qd;
        float v1 = NEG, v2 = NEG, v3 = NEG; int i1 = -1, i2 = -1, i3 = -1;
        for (int n = 0; n < qb; ++n) { const size_t o = ((size_t)(b * NBLK + n)) * 512 + h * HD + lane; const float km = KP[o] + KP[(size_t)128 * 512 + o];
            const float gt = __builtin_bit_cast(float, __builtin_amdgcn_readfirstlane(__builtin_bit_cast(int, wave_sum(qd * km))));
            if (gt > v1) { v3 = v2; i3 = i2; v2 = v1; i2 = i1; v1 = gt; i1 = n; } else if (gt > v2) { v3 = v2; i3 = i2; v2 = gt; i2 = n; } else if (gt > v3) { v3 = gt; i3 = n; } }
        LDS_WAIT(); asm volatile("" ::: "memory");
        float mx = NEG;
        for (int s = 0; s < 4; ++s) { const int blk = s == 0 ? i1 : s == 1 ? i2 : s == 2 ? i3 : qb; if (blk < 0) continue;
            for (int cch = 0; cch < 4; ++cch) { const int key = blk * MBLK + cch * 64 + lane; const f16_t* kp = K + ((size_t)(b * SEQ + key)) * AW + h * HD; float acc = 0.f;
#pragma unroll
                for (int d8 = 0; d8 < 8; ++d8) { float kv[8]; unpk8(*(const v4u*)(kp + 8 * d8), kv); const f32x4 q0 = *(const LAS f32x4*)(qs + 8 * d8), q1 = *(const LAS f32x4*)(qs + 8 * d8 + 4);
                    acc += kv[0] * q0.x + kv[1] * q0.y + kv[2] * q0.z + kv[3] * q0.w + kv[4] * q1.x + kv[5] * q1.y + kv[6] * q1.z + kv[7] * q1.w; }
                if (key > tpos) acc = NEG;
                sc[s * 256 + cch * 64 + lane] = acc; mx = fmaxf(mx, acc); } }
        mx = wave_max(mx);
        LDS_WAIT(); asm volatile("" ::: "memory");
        float ls = 0.f;
        for (int s = 0; s < 4; ++s) { const int blk = s == 0 ? i1 : s == 1 ? i2 : s == 2 ? i3 : qb; if (blk < 0) continue;
#pragma unroll
            for (int cch = 0; cch < 4; ++cch) { const float p = __builtin_amdgcn_exp2f(sc[s * 256 + cch * 64 + lane] - mx); sc[s * 256 + cch * 64 + lane] = p; ls += p; } }
        ls = wave_sum(ls);
        LDS_WAIT(); asm volatile("" ::: "memory");
        float o = 0.f;
        for (int s = 0; s < 4; ++s) { const int blk = s == 0 ? i1 : s == 1 ? i2 : s == 2 ? i3 : qb; if (blk < 0) continue;
            const f16_t* vp = V + ((size_t)(b * SEQ + blk * MBLK)) * AW + h * HD + lane;
#pragma unroll 8
            for (int kk = 0; kk < 256; ++kk) o += sc[s * 256 + kk] * h2f(vp[(size_t)kk * AW]); }
        AO[(size_t)row * AW + h * HD + lane] = f2h(o / ls);
        LDS_WAIT(); asm volatile("" ::: "memory");
    }
}
#endif

#if !OPT_FFN
__device__ __forceinline__ void ph_convact_simple(const Args& a, int l, int b, int gtid, int NT) {
    const f16_t* U = (const f16_t*)(a.ws + WS_U); f16_t* ACT = (f16_t*)(a.ws + WS_ACT);
    const float* cw = a.conv_w + (size_t)l * 3 * FF2; const float* cb = a.conv_b + (size_t)l * FF2;
    for (int it = gtid; it < SEQ * (FF / 8); it += NT) { const int t = it / (FF / 8), j0 = (it % (FF / 8)) * 8;
        float ua[8], ug[8];
#pragma unroll
        for (int e = 0; e < 8; ++e) { ua[e] = cb[j0 + e]; ug[e] = cb[FF + j0 + e]; }
#pragma unroll
        for (int i = 0; i < 3; ++i) { const int ts = t - 2 + i; if (ts >= 0) { float va[8], vg[8]; unpk8(*(const v4u*)(U + (size_t)ts * FF2 + j0), va); unpk8(*(const v4u*)(U + (size_t)ts * FF2 + FF + j0), vg);
#pragma unroll
                for (int e = 0; e < 8; ++e) { ua[e] += cw[i * FF2 + j0 + e] * va[e]; ug[e] += cw[i * FF2 + FF + j0 + e] * vg[e]; } } }
        float o[8];
#pragma unroll
        for (int e = 0; e < 8; ++e) o[e] = silu_f(ua[e]) * ug[e];
        *(v4u*)(ACT + ((size_t)(b * SEQ + t)) * FF + j0) = pk8(o); }
}
#endif

#if OPT_FFN
__device__ __forceinline__ void ph_fix(const Args& a, int l, int gtid, int NT) {
    const float* BND = (const float*)(a.ws + WS_BND); f16_t* ACT = (f16_t*)(a.ws + WS_ACT);
    const float* cw = a.conv_w + (size_t)l * 3 * FF2; const float* cb = a.conv_b + (size_t)l * FF2;
    for (int it = gtid; it < 256 * (FF / 4); it += NT) { const int grp = it / (FF / 4), j = (it % (FF / 4)) * 4;
        f32x4 uc0[2], uc1[2];
#pragma unroll
        for (int p = 0; p < 2; ++p) { const int col = p * FF + j;
            const f32x4 u0 = *(const f32x4*)(BND + ((size_t)grp * 4 + 0) * FF2 + col), u1 = *(const f32x4*)(BND + ((size_t)grp * 4 + 1) * FF2 + col);
            f32x4 p2 = (f32x4){0.f, 0.f, 0.f, 0.f}, p3 = p2;
            if ((grp & 31) != 0) { p2 = *(const f32x4*)(BND + ((size_t)(grp - 1) * 4 + 2) * FF2 + col); p3 = *(const f32x4*)(BND + ((size_t)(grp - 1) * 4 + 3) * FF2 + col); }
            const f32x4 w0 = *(const f32x4*)(cw + col), w1 = *(const f32x4*)(cw + FF2 + col), w2 = *(const f32x4*)(cw + 2 * FF2 + col), b4 = *(const f32x4*)(cb + col);
            uc0[p] = b4 + w0 * p2 + w1 * p3 + w2 * u0; uc1[p] = b4 + w0 * p3 + w1 * u0 + w2 * u1; }
        v2u o0, o1;
        o0.x = pkh(silu_f(uc0[0].x) * uc0[1].x, silu_f(uc0[0].y) * uc0[1].y); o0.y = pkh(silu_f(uc0[0].z) * uc0[1].z, silu_f(uc0[0].w) * uc0[1].w);
        o1.x = pkh(silu_f(uc1[0].x) * uc1[1].x, silu_f(uc1[0].y) * uc1[1].y); o1.y = pkh(silu_f(uc1[0].z) * uc1[1].z, silu_f(uc1[0].w) * uc1[1].w);
        *(v2u*)(ACT + ((size_t)grp * 128 + 0) * FF + j) = o0; *(v2u*)(ACT + ((size_t)grp * 128 + 1) * FF + j) = o1; }
}
#endif


#define IN(k) (lo <= (k) && (k) < hi)
#define LANE_IDS int tid = threadIdx.x; asm volatile("" : "+v"(tid)); const int lane = tid & 63, wave = __builtin_amdgcn_readfirstlane(tid >> 6); const int gw = vcu * NWAVES + wave, row0 = vcu * 128 + wave * 16; (void)lane; (void)gw; (void)row0;
#define SEAM(k) do { if (IN((k) + 1)) xcd_barrier(bar); } while (0)
template <int L> __device__ __forceinline__ void layer_phases(unsigned char* wsp, int chunk, LAS unsigned char* lds, unsigned char* ldsg, const XcdBarrier& bar, int vcu, int G, int bx, int lo, int hi) {
    constexpr int l = L; constexpr int pb = PH_L0 + L * NPL;
    if (pb >= hi || pb + NPL <= lo) return;
    unsigned char* ws = wsp;
    const int NGW = G * NWAVES, bat = vcu >> 5;
    const float* MOD = (const float*)(ws + WS_MOD);
    f16_t* H = (f16_t*)(ws + WS_H); f16_t* Y = (f16_t*)(ws + WS_Y);
        unsigned char* wl = ws + WS_W + (size_t)l * W_LAYER;
        const float* md = MOD + (size_t)(l * 8 + bat) * 6144;
        if (IN(pb + J_G1)) {
            pg8::Gemm g{H, (const f16_t*)(wl + W_IN), M, INW, DM}; pg8::StaticOrder S; S.init(M, INW, G, bx);
#if OPT_INPROJ
            pg8::EpiIn E{(f16_t*)(ws + WS_Q), (const float*)(ws + WS_ROPE), (float*)(ws + WS_KP), QSCALE};
            pg8::gemm_phase<pg8::EpiIn, pg8::StaticOrder, true, true>(lds + RING_OFF, g, S, E);
#else
            pg8::EpiF16 E{(f16_t*)(ws + WS_Q), AW, AW, (size_t)(32 * MiB / 2)};
            pg8::gemm_phase<pg8::EpiF16, pg8::StaticOrder, true, true>(lds + RING_OFF, g, S, E);
#endif
            SEAM(pb + J_G1);
        }
#if !OPT_INPROJ
        if (IN(pb + J_ROPE)) { LANE_IDS const Args args = lds_args(lds); ph_rope(args, lds, tid, lane, wave, vcu); SEAM(pb + J_ROPE); }
#endif
        if (IN(pb + J_GATE)) { LANE_IDS ph_gate(ws, lds, tid, vcu); SEAM(pb + J_GATE); }
        if (IN(pb + J_ATT)) {
#if !OPT_ATTN
            { LANE_IDS const Args args = lds_args(lds); ph_attn_simple(args, lds, lane, wave, gw, NGW); }
#else
            static_assert(attn_body::ATTN_LDS_BYTES <= RING_BYTES && attn_body::ATTN_PITCH == AW, "attention body geometry vs frame");
            const attn_body::AttnTensors AT{(const attn_body::f16*)(ws + WS_Q), (const attn_body::f16*)(ws + WS_K), (const attn_body::f16*)(ws + WS_V), (attn_body::f16*)(ws + WS_AO), (const unsigned*)(ws + WS_SEL)};
            const attn_body::StaticOrder AS(G, bx);
            attn_body::attn_phase<attn_body::StaticOrder>((char*)ldsg + RING_OFF, AT, AS);
#endif
            SEAM(pb + J_ATT);
        }
        if (IN(pb + J_MERGE)) { LANE_IDS const Args args = lds_args(lds); ph_merge(args, l, (const f16_t*)(ws + WS_AO), (const f16_t*)(ws + WS_R), (f16_t*)(ws + WS_MG), (LAS float*)(lds + wave * 4096), row0, lane); SEAM(pb + J_MERGE); }
        if (IN(pb + J_G2)) {
            pg8::Gemm g{(const f16_t*)(ws + WS_MG), (const f16_t*)(wl + W_OUT), M, DM, DM}; pg8::StaticOrder S; S.init(M, DM, G, bx);
            pg8::EpiF16 E{Y, DM, 0, 0};
            pg8::gemm_phase<pg8::EpiF16, pg8::StaticOrder, true, true>(lds + RING_OFF, g, S, E);
            SEAM(pb + J_G2);
        }
        if (IN(pb + J_POST1)) { LANE_IDS const Args args = lds_args(lds); ph_post<(L > 0), true>(Y, L == 0 ? (const void*)args.x : (const void*)(ws + WS_X16), (void*)(ws + WS_X16), args.g_post_mix + l * DM, md + 2048, true, args.g_pre_ffn + l * DM, md + 4096, md + 3072, H, row0, lane); SEAM(pb + J_POST1); }
        if (IN(pb + J_G3)) {
            const Args args = lds_args(lds);
#if !OPT_FFN
            pg8::Gemm g{H + (size_t)chunk * SEQ * DM, (const f16_t*)(wl + W_UP), SEQ, FF2, DM}; pg8::StaticOrder S; S.init(SEQ, FF2, G, bx);
            pg8::EpiF16 E{(f16_t*)(ws + WS_U), FF2, 0, 0};
            pg8::gemm_phase<pg8::EpiF16, pg8::StaticOrder, true, true>(lds + RING_OFF, g, S, E);
#else
            pg8::Gemm g{H, (const f16_t*)(wl + W_UP), M, FF2, DM}; pg8::StaticOrder S; S.init(M, FF2, G, bx);
            pg8::EpiUp E{(f16_t*)(ws + WS_ACT), (float*)(ws + WS_BND), args.conv_w + (size_t)l * 3 * FF2, args.conv_b + (size_t)l * FF2, (LAS float*)(lds + EPI_LDS_OFF)};
            pg8::gemm_phase<pg8::EpiUp, pg8::StaticOrder, true, true>(lds + RING_OFF, g, S, E);
#endif
            SEAM(pb + J_G3);
        }
        if (IN(pb + J_FIX)) {
            LANE_IDS const Args args = lds_args(lds);
#if !OPT_FFN
            ph_convact_simple(args, l, chunk, bx * 512 + tid, G * 512);
#else
            ph_fix(args, l, bx * 512 + tid, G * 512);
#endif
            SEAM(pb + J_FIX);
        }
        if (IN(pb + J_G4)) {
            pg8::Gemm g{(const f16_t*)(ws + WS_ACT), (const f16_t*)(wl + W_DOWN), M, DM, FF}; pg8::StaticOrder S; S.init(M, DM, G, bx);
            pg8::EpiF16 E{Y, DM, 0, 0};
            pg8::gemm_phase<pg8::EpiF16, pg8::StaticOrder, true, true>(lds + RING_OFF, g, S, E);
            SEAM(pb + J_G4);
        }
        if (IN(pb + J_POST2)) { LANE_IDS const Args args = lds_args(lds); const bool nx = (l + 1 < DEPTH); const float* mdn = MOD + (size_t)((nx ? l + 1 : l) * 8 + bat) * 6144;
            ph_post<true, (L + 1 < DEPTH)>(Y, (const void*)(ws + WS_X16), (L + 1 < DEPTH) ? (void*)(ws + WS_X16) : (void*)args.out, args.g_post_ffn + l * DM, md + 5120, nx, args.g_pre_mix + (nx ? l + 1 : l) * DM, mdn + 1024, mdn, H, row0, lane); SEAM(pb + J_POST2); }
}
__global__ void __launch_bounds__(NWAVES * 64, 2) fwd_kernel(Args args) {
    extern __shared__ __attribute__((aligned(16))) unsigned char lds_raw[];
    LAS unsigned char* lds = (LAS unsigned char*)lds_raw;
    volatile LAS unsigned* MISC = (volatile LAS unsigned*)(lds + MISC_OFF);
    const int G = gridDim.x; const int bx = blockIdx.x; const int vcu = (G % 8 == 0) ? (bx % 8) * (G / 8) + bx / 8 : bx;
    unsigned char* ws = args.ws;
    gu32* ctl = (gu32*)(ws + WS_CTL);
    for (int u = threadIdx.x; u < (LDS_BYTES - LDSCTL_OFF) / 4; u += NWAVES * 64) ((LAS unsigned*)(lds + LDSCTL_OFF))[u] = 0u;
    __syncthreads();
    if (threadIdx.x == 0) { LAS unsigned long long* la = (LAS unsigned long long*)(lds + ARGS_OFF);
        la[0] = (unsigned long long)args.x; la[1] = (unsigned long long)args.c; la[2] = (unsigned long long)args.w_ada; la[3] = (unsigned long long)args.b_ada; la[4] = (unsigned long long)args.g_pre_mix;
        la[5] = (unsigned long long)args.w_in; la[6] = (unsigned long long)args.w_pool; la[7] = (unsigned long long)args.pool_scale; la[8] = (unsigned long long)args.attn_out_gain; la[9] = (unsigned long long)args.pool_out_gain;
        la[10] = (unsigned long long)args.w_out; la[11] = (unsigned long long)args.g_post_mix; la[12] = (unsigned long long)args.g_pre_ffn; la[13] = (unsigned long long)args.w_up; la[14] = (unsigned long long)args.conv_w;
        la[15] = (unsigned long long)args.conv_b; la[16] = (unsigned long long)args.w_down; la[17] = (unsigned long long)args.g_post_ffn; la[18] = (unsigned long long)args.out; la[19] = (unsigned long long)args.ws; }
    __syncthreads();
    XcdBarrier bar = xcd_barrier_post((unsigned*)(ctl + CW_BAR) + args.li * XCD_BAR_WORDS, MISC + 8);
    const int lo = args.ph_lo, hi = args.ph_hi;
    const int bat = vcu >> 5;
    const float* MOD = (const float*)(ws + WS_MOD);
    f16_t* H = (f16_t*)(ws + WS_H); f16_t* Y = (f16_t*)(ws + WS_Y);

    if (IN(PH_PRO)) { LANE_IDS const Args la = lds_args(lds); ph_prologue(la, lds, tid, lane, wave, vcu, G); SEAM(PH_PRO); }
    if (IN(PH_PRE)) { LANE_IDS const Args la = lds_args(lds); const float* md = MOD + (size_t)(0 * 8 + bat) * 6144; ph_pre(la.x, la.g_pre_mix, md + 1024, md, H, row0, lane); SEAM(PH_PRE); }

    layer_phases<0>(ws, args.chunk, lds, lds_raw, bar, vcu, G, bx, lo, hi);
    layer_phases<1>(ws, args.chunk, lds, lds_raw, bar, vcu, G, bx, lo, hi);
}
#undef IN
#undef SEAM


static void launch_range(const Args& base, int lo, int hi, int li, int chunk, hipStream_t stream) {
    Args a = base; a.ph_lo = lo; a.ph_hi = hi; a.li = li; a.chunk = chunk;
    hipLaunchKernelGGL(fwd_kernel, dim3(256), dim3(NWAVES * 64), LDS_BYTES, stream, a);
    const hipError_t le = hipPeekAtLastError();
    if (le != hipSuccess) fprintf(stderr, "kernel_launch: launch [%d,%d) failed: %s\n", lo, hi, hipGetErrorName(le));
}
extern "C" void kernel_launch(void* const* d_in, const int* in_sizes, int n_in, void* d_out, int out_size, void* d_ws, size_t ws_size, hipStream_t stream) {
    static int ready = 0;
    if (ready == 0) {
        if (n_in != 18 || in_sizes[0] != M * DM || out_size != M * DM || ws_size < WS_END) { fprintf(stderr, "kernel_launch: unexpected shapes (n_in %d, in0 %d, out %d, ws %zu); nothing launched\n", n_in, n_in > 0 ? in_sizes[0] : -1, out_size, ws_size); ready = -1; return; }
        if (hipFuncSetAttribute((const void*)fwd_kernel, hipFuncAttributeMaxDynamicSharedMemorySize, LDS_BYTES) != hipSuccess) { fprintf(stderr, "kernel_launch: hipFuncSetAttribute failed\n"); ready = -1; return; }
        int per_cu = 0;
        if (hipOccupancyMaxActiveBlocksPerMultiprocessor(&per_cu, (const void*)fwd_kernel, NWAVES * 64, LDS_BYTES) != hipSuccess || per_cu < 1) fprintf(stderr, "kernel_launch: note: occupancy query reports %d workgroups per CU\n", per_cu);
        (void)hipGetLastError();
        ready = 1;
    }
    if (ready < 0) return;
    if (hipMemsetAsync((char*)d_ws + WS_CTL, 0, CTL_ZERO_BYTES, stream) != hipSuccess) { fprintf(stderr, "kernel_launch: hipMemsetAsync failed\n"); return; }
    Args a{};
    a.x = (const float*)d_in[0]; a.c = (const float*)d_in[1]; a.w_ada = (const float*)d_in[2]; a.b_ada = (const float*)d_in[3]; a.g_pre_mix = (const float*)d_in[4]; a.w_in = (const float*)d_in[5];
    a.w_pool = (const float*)d_in[6]; a.pool_scale = (const float*)d_in[7]; a.attn_out_gain = (const float*)d_in[8]; a.pool_out_gain = (const float*)d_in[9]; a.w_out = (const float*)d_in[10];
    a.g_post_mix = (const float*)d_in[11]; a.g_pre_ffn = (const float*)d_in[12]; a.w_up = (const float*)d_in[13]; a.conv_w = (const float*)d_in[14]; a.conv_b = (const float*)d_in[15];
    a.w_down = (const float*)d_in[16]; a.g_post_ffn = (const float*)d_in[17];
    a.out = (float*)d_out; a.ws = (unsigned char*)d_ws;
#if ONE_LAUNCH
    launch_range(a, 0, NPH, 0, 0, stream);
#else
    launch_range(a, PH_PRO, PH_PRO + 1, 0, 0, stream);
    launch_range(a, PH_PRE, PH_PRE + 1, 0, 0, stream);
    for (int l = 0; l < DEPTH; ++l) { const int pb = PH_L0 + l * NPL;
        for (int j = 0; j < NPL; ++j) {
#if !OPT_FFN
            if (j == J_G3) { for (int ch = 0; ch < BATCH; ++ch) { launch_range(a, pb + J_G3, pb + J_G3 + 1, 0, ch, stream); launch_range(a, pb + J_FIX, pb + J_FIX + 1, 0, ch, stream); } continue; }
            if (j == J_FIX) continue;
#endif
            launch_range(a, pb + j, pb + j + 1, 0, 0, stream);
        }
    }
#endif
}
```

```cpp
#include <hip/hip_runtime.h>
#include <cstdio>
#include <cstdint>
#include <cmath>


constexpr int HWTID_LDS_ADDR = 131072 + 512;
__device__ __forceinline__ int hw_tid() {
    const unsigned slot = (unsigned)__builtin_amdgcn_s_getreg(((6 - 1) << 11) | 4);
    const unsigned w = ((const volatile __attribute__((address_space(3))) unsigned*)(unsigned long)HWTID_LDS_ADDR)[slot];
    unsigned l; asm volatile("v_mbcnt_lo_u32_b32 %0, -1, 0\n\tv_mbcnt_hi_u32_b32 %0, -1, %0" : "=v"(l));
    return (int)(((unsigned)__builtin_amdgcn_readfirstlane((int)w) << 6) | l);
}
constexpr int BATCH = 8, SEQ = 4096, DM = 1024, M = BATCH * SEQ, DEPTH = 2;
constexpr int AW = 512, NH = 8, HD = 64, PW = 512, INW = 2048, FF = 2816, FF2 = 5632, NBLK = 16, MBLK = 256;
constexpr float NORM_EPS = 1e-6f;
constexpr float QSCALE = 0.125f * 1.4426950408889634f;

namespace pg8 {
#define PG8_LAS __attribute__((address_space(3)))
typedef unsigned short f16_t;
typedef _Float16 h16x8 __attribute__((ext_vector_type(8)));
typedef _Float16 h16x2 __attribute__((ext_vector_type(2)));
typedef float f32x4 __attribute__((ext_vector_type(4)));
typedef float f32x2 __attribute__((ext_vector_type(2)));
typedef unsigned u32x4 __attribute__((ext_vector_type(4)));
typedef unsigned u32x2 __attribute__((ext_vector_type(2)));
typedef int i32x4v __attribute__((ext_vector_type(4)));
constexpr int BM = 256, BK = 64, HALF = 128, HTB = HALF * BK * 2  , STAGE_BYTES = 8 * HTB, NXCD = 8, WGM = 8;

__host__ __device__ __forceinline__ int lds_byte(int r, int c) { const int st = (r >> 4) * 2 + (c >> 5), rr = r & 15, cc = c & 31, ob = rr * 64 + cc * 2; return st * 1024 + (ob ^ (((ob >> 9) & 1) << 5)); }
__host__ __device__ __forceinline__ void stage_rc(int b, int& R, int& C) { const int st = b / 1024, sb = b % 1024, swz = sb ^ (((sb >> 9) & 1) << 5); R = (st >> 1) * 16 + swz / 64; C = (st & 1) * 32 + (swz % 64) / 2; }
__host__ __device__ __forceinline__ int perm32(int rho) { const int n = rho >> 4, i = rho & 15; return 8 * (i >> 2) + 4 * n + (i & 3); }

struct Unit { int pm, pn; };
struct Gemm { const f16_t* A; const f16_t* Bt; int M, N, K; };

struct StaticOrder {
    int nM, nN, nwg, G, c;
    __host__ __device__ void init(int M_, int N_, int G_, int c_) { nM = M_ / BM; nN = N_ / BM; nwg = nM * nN; G = G_; c = c_; }
    __host__ __device__ bool next(int i, Unit& u) const {
        const long L = (long)i * G + c; if (L >= nwg) return false;
        int wgid = (int)L; { const int q = nwg / NXCD, r = nwg % NXCD, xcd = wgid % NXCD, off = wgid / NXCD; wgid = (xcd < r ? xcd * (q + 1) : r * (q + 1) + (xcd - r) * q) + off; }
        const int nig = WGM * nN, gid = wgid / nig, fm = gid * WGM, gsz = (nM - fm) < WGM ? (nM - fm) : WGM;
        u.pm = fm + ((wgid % nig) % gsz); u.pn = (wgid % nig) / gsz; return true;
    }
    __device__ __forceinline__ void a_ready(const Unit&) const {}
    __device__ __forceinline__ void done(const Unit&) const {}
};

__device__ __forceinline__ unsigned cvt_pk_f16(float lo, float hi) { const f32x2 v = {lo, hi}; const h16x2 h = __builtin_convertvector(v, h16x2); return __builtin_bit_cast(unsigned, h); }

__device__ __forceinline__ unsigned pk4_fp8(float a, float b, float c, float d) {
    a = __builtin_amdgcn_fmed3f(a, -448.f, 448.f); b = __builtin_amdgcn_fmed3f(b, -448.f, 448.f); c = __builtin_amdgcn_fmed3f(c, -448.f, 448.f); d = __builtin_amdgcn_fmed3f(d, -448.f, 448.f);
    unsigned w = 0u; w = (unsigned)__builtin_amdgcn_cvt_pk_fp8_f32(a, b, (int)w, false); w = (unsigned)__builtin_amdgcn_cvt_pk_fp8_f32(c, d, (int)w, true); return w; }
constexpr float ACT_SCALE = 8.f, WD_SCALE = 1024.f;
struct EpiF16 {
    static constexpr bool PERM = true, AFTER_DRAIN = false, APERM = false;
    f16_t* O; int ldc; int split_cols; size_t split_stride; float scale;
    __device__ __forceinline__ void operator()(const f32x4 (&acc)[2][2][4][2], const Unit& u, int wr, int wc, int fr, int fq) const {
        const int row0 = u.pm * BM + wr * 64 + fr; int colt = u.pn * BM; f16_t* base = O;
        if (split_cols) { const int t = colt / split_cols; base += (size_t)t * split_stride; colt -= t * split_cols; }
        const int col0 = colt + wc * 32 + 8 * fq;
#pragma unroll
        for (int ai = 0; ai < 2; ++ai)
#pragma unroll
            for (int m = 0; m < 4; ++m) { f16_t* rowp = base + (size_t)(row0 + ai * HALF + m * 16) * ldc + col0;
#pragma unroll
                for (int bj = 0; bj < 2; ++bj) { const f32x4 v0 = acc[ai][bj][m][0] * scale, v1 = acc[ai][bj][m][1] * scale;
                    u32x4 w; w.x = cvt_pk_f16(v0[0], v0[1]); w.y = cvt_pk_f16(v0[2], v0[3]); w.z = cvt_pk_f16(v1[0], v1[1]); w.w = cvt_pk_f16(v1[2], v1[3]);
                    *(u32x4*)(rowp + bj * HALF) = w; } }
    }
};

struct EpiI8F16 {
    static constexpr bool PERM = true, AFTER_DRAIN = false, APERM = false;
    f16_t* O; int ldc; const float* sA; const float* cmax;
    __device__ __forceinline__ void operator()(const f32x4 (&acc)[2][2][4][2], const Unit& u, int wr, int wc, int fr, int fq) const {
        const int row0 = u.pm * BM + wr * 64 + fr, col0 = u.pn * BM + wc * 32 + 8 * fq;
        f32x4 cs[2][2];
#pragma unroll
        for (int bj = 0; bj < 2; ++bj)
#pragma unroll
            for (int n = 0; n < 2; ++n) cs[bj][n] = *(const f32x4*)(cmax + col0 + bj * HALF + 4 * n) * (1.0f / 127.0f);
#pragma unroll
        for (int ai = 0; ai < 2; ++ai)
#pragma unroll
            for (int m = 0; m < 4; ++m) { const int row = row0 + ai * HALF + m * 16; const float ra = sA[row]; f16_t* rowp = O + (size_t)row * ldc + col0;
#pragma unroll
                for (int bj = 0; bj < 2; ++bj) { const i32x4v i0 = __builtin_bit_cast(i32x4v, acc[ai][bj][m][0]), i1 = __builtin_bit_cast(i32x4v, acc[ai][bj][m][1]);
                    const f32x4 v0 = __builtin_convertvector(i0, f32x4) * ra * cs[bj][0], v1 = __builtin_convertvector(i1, f32x4) * ra * cs[bj][1];
                    u32x4 w; w.x = cvt_pk_f16(v0[0], v0[1]); w.y = cvt_pk_f16(v0[2], v0[3]); w.z = cvt_pk_f16(v1[0], v1[1]); w.w = cvt_pk_f16(v1[2], v1[3]);
                    *(u32x4*)(rowp + bj * HALF) = w; } }
    }
};

struct EpiIn {
    static constexpr bool PERM = true, AFTER_DRAIN = false, APERM = false;
    f16_t* QKVR; const float* ROPE; float* KP; float qscale; size_t tstride;
    __device__ __forceinline__ void operator()(const f32x4 (&acc)[2][2][4][2], const Unit& u, int wr, int wc, int fr, int fq) const {
        const int t = u.pn >> 1; f16_t* base = QKVR + (size_t)t * tstride;
        const int col0 = (u.pn & 1) * 256 + wc * 32 + 8 * fq, row0 = u.pm * BM + wr * 64 + fr;
        const bool rot = (t < 2) && ((wc & 1) == 0);
        const float sgn = fq == 0 ? -1.f : 1.f; const bool rl = fq < 2; const float qs = t == 0 ? qscale : 1.f;
        f32x4 ks[2][2];
#pragma unroll
        for (int bj = 0; bj < 2; ++bj)
#pragma unroll
            for (int n = 0; n < 2; ++n) ks[bj][n] = (f32x4){0.f, 0.f, 0.f, 0.f};
        f32x4 rn[4];
#pragma unroll
        for (int i = 0; i < 4; ++i) rn[i] = (f32x4){0.f, 0.f, 0.f, 0.f};
        if (rot) { const float* rp = ROPE + (size_t)(row0 & 4095) * 16;
#pragma unroll
            for (int i = 0; i < 4; ++i) rn[i] = *(const f32x4*)(rp + 4 * i); }
#pragma unroll
        for (int ai = 0; ai < 2; ++ai)
#pragma unroll
            for (int m = 0; m < 4; ++m) { const int row = row0 + ai * HALF + m * 16;
                f32x4 rc[4];
#pragma unroll
                for (int i = 0; i < 4; ++i) rc[i] = rn[i];
                if (rot && !(ai == 1 && m == 3)) { const int rown = (m == 3) ? row0 + HALF : row + 16; const float* rp = ROPE + (size_t)(rown & 4095) * 16;
#pragma unroll
                    for (int i = 0; i < 4; ++i) rn[i] = *(const f32x4*)(rp + 4 * i); }
                f32x4 v[2][2];
#pragma unroll
                for (int bj = 0; bj < 2; ++bj)
#pragma unroll
                    for (int n = 0; n < 2; ++n) v[bj][n] = acc[ai][bj][m][n];
                if (rot) { f32x4 cs[2], sn[2]; cs[0] = rc[0]; cs[1] = rc[1]; sn[0] = rc[2]; sn[1] = rc[3];
#pragma unroll
                    for (int bj = 0; bj < 2; ++bj)
#pragma unroll
                        for (int n = 0; n < 2; ++n)
#pragma unroll
                            for (int e = 0; e < 4; ++e) { const float x = v[bj][n][e], px = __shfl_xor(x, 16); const float r = x * cs[n][e] + sgn * px * sn[n][e]; v[bj][n][e] = rl ? r : x; } }
                if (t == 1) {
#pragma unroll
                    for (int bj = 0; bj < 2; ++bj)
#pragma unroll
                        for (int n = 0; n < 2; ++n) ks[bj][n] += v[bj][n];
                }
                f16_t* rowp = base + (size_t)row * 512 + col0;
#pragma unroll
                for (int bj = 0; bj < 2; ++bj) { const f32x4 v0 = v[bj][0] * qs, v1 = v[bj][1] * qs;
                    u32x4 w; w.x = cvt_pk_f16(v0[0], v0[1]); w.y = cvt_pk_f16(v0[2], v0[3]); w.z = cvt_pk_f16(v1[0], v1[1]); w.w = cvt_pk_f16(v1[2], v1[3]);
                    *(u32x4*)(rowp + bj * HALF) = w; }
                asm volatile("" ::: "memory"); __builtin_amdgcn_sched_barrier(0);
            }
        if (t == 1) {
#pragma unroll
            for (int bj = 0; bj < 2; ++bj)
#pragma unroll
                for (int n = 0; n < 2; ++n) { f32x4 s = ks[bj][n];
#pragma unroll
                    for (int o = 1; o < 16; o <<= 1) { s.x += __shfl_xor(s.x, o); s.y += __shfl_xor(s.y, o); s.z += __shfl_xor(s.z, o); s.w += __shfl_xor(s.w, o); }
                    if (fr == 0) *(f32x4*)(KP + ((size_t)(wr * 128 + u.pm)) * 512 + (u.pn & 1) * 256 + bj * HALF + wc * 32 + 8 * fq + 4 * n) = s; }
        }
    }
};

__device__ __forceinline__ float dpp_row_shr1(float v) { return __builtin_bit_cast(float, __builtin_amdgcn_update_dpp(0, __builtin_bit_cast(int, v), 0x111, 0xF, 0xF, true)); }
__device__ __forceinline__ float dpp_row_ror1(float v) { return __builtin_bit_cast(float, __builtin_amdgcn_update_dpp(0, __builtin_bit_cast(int, v), 0x121, 0xF, 0xF, true)); }
__device__ __forceinline__ f32x4 shr1_4(f32x4 v) { return (f32x4){dpp_row_shr1(v.x), dpp_row_shr1(v.y), dpp_row_shr1(v.z), dpp_row_shr1(v.w)}; }
__device__ __forceinline__ f32x4 ror1_4(f32x4 v) { return (f32x4){dpp_row_ror1(v.x), dpp_row_ror1(v.y), dpp_row_ror1(v.z), dpp_row_ror1(v.w)}; }
__device__ __forceinline__ float silu1(float a) { return a * __builtin_amdgcn_rcpf(1.0f + __builtin_amdgcn_exp2f(-1.4426950408889634f * a)); }
__device__ __forceinline__ f32x2 silu_mul2(f32x2 a, f32x2 g) { const f32x2 t = a * (-1.4426950408889634f); f32x2 e; e.x = __builtin_amdgcn_exp2f(t.x); e.y = __builtin_amdgcn_exp2f(t.y);
    const f32x2 d = e + 1.0f; f32x2 r; r.x = __builtin_amdgcn_rcpf(d.x); r.y = __builtin_amdgcn_rcpf(d.y); return (a * g) * r; }
struct EpiUp {
    static constexpr bool PERM = true, AFTER_DRAIN = false, APERM = true;
    unsigned char* ACT; float* BND; const float* cw; const float* cb;
    const float* sA; const float* cmax;
    PG8_LAS float* cwl;
    __device__ __forceinline__ void operator()(const f32x4 (&acc)[2][2][4][2], const Unit& u, int wr, int wc, int fr, int fq) const {
        const int j0 = u.pn * 128 + wc * 32 + 8 * fq;
        const int grp = 2 * u.pm + wr;
        PG8_LAS float* slot = cwl + (wr * 4 + wc) * 256;
        { const int lane = fq * 16 + fr, vec = lane >> 4, bjl = (lane >> 3) & 1, c4 = (lane & 7) * 4; const float* src = (vec < 3 ? cw + vec * 5632 : cb) + bjl * 2816 + u.pn * 128 + wc * 32 + c4;
          f32x4 cv = *(const f32x4*)src; if (vec < 3) cv = cv * (*(const f32x4*)(cmax + bjl * 2816 + u.pn * 128 + wc * 32 + c4) * (1.0f / 127.0f));
          *(PG8_LAS f32x4*)(slot + vec * 64 + bjl * 32 + c4) = cv; }
        f32x4 sa[2];
        sa[0] = *(const f32x4*)(sA + (size_t)grp * 128 + 4 * fr); sa[1] = *(const f32x4*)(sA + (size_t)grp * 128 + 64 + 4 * fr);
#define EUP_U(ai_, bj_, m_, n_) (__builtin_convertvector(__builtin_bit_cast(i32x4v, acc[ai_][bj_][m_][n_]), f32x4) * sa[ai_][m_])
        if (fr == 0 || fr == 15) {
#pragma unroll
            for (int mm = 0; mm < 2; ++mm) { const int m = fr == 0 ? mm : 2 + mm;
#pragma unroll
                for (int bj = 0; bj < 2; ++bj)
#pragma unroll
                    for (int n = 0; n < 2; ++n) { const f32x4 cs = *(const f32x4*)(cmax + bj * 2816 + j0 + 4 * n) * (1.0f / 127.0f);
                        const f32x4 v = (fr == 0 ? EUP_U(0, bj, mm, n) : EUP_U(1, bj, 2 + mm, n)) * cs; *(f32x4*)(BND + ((size_t)grp * 4 + m) * 5632 + bj * 2816 + j0 + 4 * n) = v; } } }
#pragma unroll
        for (int aii = 0; aii < 2; ++aii) { const int ai = 1 - aii;
            unsigned pk0[4];
#pragma unroll
            for (int n = 0; n < 2; ++n) {
                f32x4 ua[4];
#pragma unroll
                for (int bj = 0; bj < 2; ++bj) {
                    const PG8_LAS float* sp = slot + bj * 32 + 8 * fq + 4 * n;
                    const f32x4 w0 = *(const PG8_LAS f32x4*)sp, w1 = *(const PG8_LAS f32x4*)(sp + 64), w2 = *(const PG8_LAS f32x4*)(sp + 128), b4 = *(const PG8_LAS f32x4*)(sp + 192);
                    const f32x4 U0 = EUP_U(ai, bj, 0, n), U1 = EUP_U(ai, bj, 1, n), U2 = EUP_U(ai, bj, 2, n), U3 = EUP_U(ai, bj, 3, n);
                    f32x4 P2, P3;
                    if (ai == 0) { P2 = shr1_4(U2); P3 = shr1_4(U3); }
                    else { const f32x4 S2 = fr == 15 ? EUP_U(0, bj, 2, n) : U2, S3 = fr == 15 ? EUP_U(0, bj, 3, n) : U3; P2 = ror1_4(S2); P3 = ror1_4(S3); }
                    f32x4 uc[4];
                    uc[0] = b4 + w0 * P2 + w1 * P3 + w2 * U0;
                    uc[1] = b4 + w0 * P3 + w1 * U0 + w2 * U1;
                    uc[2] = b4 + w0 * U0 + w1 * U1 + w2 * U2;
                    uc[3] = b4 + w0 * U1 + w1 * U2 + w2 * U3;
                    if (bj == 0) {
#pragma unroll
                        for (int m = 0; m < 4; ++m) ua[m] = uc[m];
                    } else {
#pragma unroll
                        for (int m = 0; m < 4; ++m) { const f32x4 a4 = ua[m], g4 = uc[m];
                            const f32x2 o01 = silu_mul2((f32x2){a4.x, a4.y}, (f32x2){g4.x, g4.y}), o23 = silu_mul2((f32x2){a4.z, a4.w}, (f32x2){g4.z, g4.w});
                            const unsigned p = pk4_fp8(o01.x * ACT_SCALE, o01.y * ACT_SCALE, o23.x * ACT_SCALE, o23.y * ACT_SCALE);
                            if (n == 0) { pk0[m] = p; }
                            else { const size_t row = (size_t)grp * 128 + 64 * ai + 4 * fr + m; u32x2 w; w.x = pk0[m]; w.y = p;
                                if (!(ai == 0 && m < 2 && fr == 0)) *(u32x2*)(ACT + row * 2816 + j0) = w; } }
                    }
                    asm volatile("" ::: "memory"); __builtin_amdgcn_sched_barrier(0);
                }
            }
        }
    }
};
#undef EUP_U
typedef int i32x4 __attribute__((ext_vector_type(4)));
typedef int i32x8 __attribute__((ext_vector_type(8)));
__device__ __forceinline__ const char* pg8_uni(const char* p) { const unsigned long long v = (unsigned long long)p; const unsigned lo = __builtin_amdgcn_readfirstlane((unsigned)v), hi = __builtin_amdgcn_readfirstlane((unsigned)(v >> 32)); return (const char*)(((unsigned long long)hi << 32) | lo); }
template <int MODE> __device__ __forceinline__ f32x4 mma_ktile(const h16x8 b0, const h16x8 b1, const h16x8 a0, const h16x8 a1, f32x4 c) {
    if constexpr (MODE == 2) {
        i32x4 ci = __builtin_bit_cast(i32x4, c);
        ci = __builtin_amdgcn_mfma_i32_16x16x64_i8(__builtin_bit_cast(i32x4, b0), __builtin_bit_cast(i32x4, a0), ci, 0, 0, 0);
        ci = __builtin_amdgcn_mfma_i32_16x16x64_i8(__builtin_bit_cast(i32x4, b1), __builtin_bit_cast(i32x4, a1), ci, 0, 0, 0);
        return __builtin_bit_cast(f32x4, ci);
    } else if constexpr (MODE == 1) {
        const i32x4 bl = __builtin_bit_cast(i32x4, b0), bh = __builtin_bit_cast(i32x4, b1), al = __builtin_bit_cast(i32x4, a0), ah = __builtin_bit_cast(i32x4, a1);
        const i32x8 B = __builtin_shufflevector(bl, bh, 0, 1, 2, 3, 4, 5, 6, 7), A = __builtin_shufflevector(al, ah, 0, 1, 2, 3, 4, 5, 6, 7);
        return __builtin_amdgcn_mfma_scale_f32_16x16x128_f8f6f4(B, A, c, 0, 0, 0, 0x7F7F7F7F, 0, 0x7F7F7F7F);
    } else {
        c = __builtin_amdgcn_mfma_f32_16x16x32_f16(b0, a0, c, 0, 0, 0); return __builtin_amdgcn_mfma_f32_16x16x32_f16(b1, a1, c, 0, 0, 0);
    }
}
template <class Epi, class Sched, bool ALIGN_EPI = false, bool SP2 = false, int MODE = 0>
__device__ __forceinline__ void gemm_phase(PG8_LAS unsigned char* lds, const Gemm g, const Sched& S, const Epi& E) {
    const int tid = hw_tid();
    const int wid = __builtin_amdgcn_readfirstlane(tid >> 6), lane = tid & 63, wr = wid >> 2, wc = wid & 3, fr = lane & 15, fq = lane >> 4;
    const int K = g.K, nt = K / BK;
    unsigned voffA[2], voffB[2];
#pragma unroll
    for (int i = 0; i < 2; ++i) { int R, C; stage_rc(tid * 16 + i * 8192, R, C); const int Rb = Epi::PERM ? ((R & ~31) + perm32(R & 31)) : R;
        const int Ra = Epi::APERM ? (128 * (R >> 6) + 4 * (R & 15) + ((R >> 4) & 3)) : R;
        voffA[i] = (unsigned)(Ra * K + C) * 2u; voffB[i] = (unsigned)(Rb * K + C) * 2u; }
    const size_t kstep = (size_t)(BK * 2);
    const size_t hstepB = (size_t)HALF * K * 2;
    const size_t hstepA = Epi::APERM ? (size_t)64 * K * 2 : hstepB;
    const size_t tstep = 2 * hstepB;
    const unsigned ldsw = (unsigned)wid * 1024u;
    const int aoff = lds_byte(wr * 64 + fr, fq * 8), boff = lds_byte(wc * 32 + fr, fq * 8);
#define PG8_SA(b, h) (((b) * 2 + (h)) * HTB)
#define PG8_SB(b, h) ((4 + (b) * 2 + (h)) * HTB)
#define PG8_STAGE(bufoff, gbase, voff) do { const char* _gb = pg8_uni((const char*)(gbase)); _Pragma("unroll") for (int _i = 0; _i < 2; ++_i) \
        __builtin_amdgcn_global_load_lds((const unsigned*)(_gb + (voff)[_i]), (PG8_LAS unsigned*)(lds + (bufoff) + ldsw + _i * 8192), 16, 0, 0); } while (0)
#define PG8_LDA(dst, b, h) do { _Pragma("unroll") for (int m = 0; m < 4; ++m) _Pragma("unroll") for (int k = 0; k < 2; ++k) dst[m][k] = *(const PG8_LAS h16x8*)(lds + PG8_SA(b, h) + aoff + m * 2048 + k * 1024); } while (0)
#define PG8_LDB(dst, b, h) do { _Pragma("unroll") for (int n = 0; n < 2; ++n) _Pragma("unroll") for (int k = 0; k < 2; ++k) dst[n][k] = *(const PG8_LAS h16x8*)(lds + PG8_SB(b, h) + boff + n * 2048 + k * 1024); } while (0)
#define PG8_MMA(ai, bj, At, Bt) do { __builtin_amdgcn_s_setprio(1); _Pragma("unroll") for (int m = 0; m < 4; ++m) _Pragma("unroll") for (int n = 0; n < 2; ++n) \
        acc[ai][bj][m][n] = mma_ktile<MODE>(Bt[n][0], Bt[n][1], At[m][0], At[m][1], acc[ai][bj][m][n]); __builtin_amdgcn_s_setprio(0); } while (0)
#define PG8_WAIT_V(n) asm volatile("s_waitcnt vmcnt(" #n ")" ::: "memory")
#define PG8_WAIT_L(n) asm volatile("s_waitcnt lgkmcnt(" #n ")" ::: "memory")
#define PG8_BAR __builtin_amdgcn_s_barrier()
#define PG8_SCHED __builtin_amdgcn_sched_barrier(0)
    Unit cur, nxt; int ui = 0;
    if (!S.next(0, cur)) return;
    f32x4 acc[2][2][4][2];
#pragma unroll
    for (int a = 0; a < 2; ++a)
#pragma unroll
        for (int b = 0; b < 2; ++b)
#pragma unroll
            for (int m = 0; m < 4; ++m)
#pragma unroll
                for (int n = 0; n < 2; ++n) acc[a][b][m][n] = (f32x4){0.f, 0.f, 0.f, 0.f};
    h16x8 At[4][2], B0[2][2], B1[2][2];
    const char* cA = (const char*)g.A + (size_t)cur.pm * tstep; const char* cB = (const char*)g.Bt + (size_t)cur.pn * tstep;
    S.a_ready(cur);
    if constexpr (SP2) {
        PG8_STAGE(PG8_SB(0, 0), cB, voffB); PG8_STAGE(PG8_SB(0, 1), cB + hstepB, voffB); PG8_STAGE(PG8_SA(0, 0), cA, voffA); PG8_STAGE(PG8_SA(0, 1), cA + hstepA, voffA);
        if (wr == 1) PG8_BAR;
        PG8_WAIT_V(2); PG8_BAR;
        PG8_STAGE(PG8_SB(1, 0), cB + kstep, voffB); PG8_STAGE(PG8_SA(1, 0), cA + kstep, voffA); PG8_STAGE(PG8_SB(1, 1), cB + hstepB + kstep, voffB);
        PG8_WAIT_V(6); PG8_BAR;
    } else {
        PG8_STAGE(PG8_SB(0, 0), cB, voffB); PG8_STAGE(PG8_SA(0, 0), cA, voffA); PG8_STAGE(PG8_SB(0, 1), cB + hstepB, voffB); PG8_STAGE(PG8_SA(0, 1), cA + hstepA, voffA);
        if (wr == 1) PG8_BAR;
        PG8_WAIT_V(4); PG8_BAR;
        PG8_STAGE(PG8_SB(1, 0), cB + kstep, voffB); PG8_STAGE(PG8_SA(1, 0), cA + kstep, voffA); PG8_STAGE(PG8_SB(1, 1), cB + hstepB + kstep, voffB);
        PG8_WAIT_V(6); PG8_BAR;
    }
    for (;;) {
        const bool has_next = S.next(ui + 1, nxt);
        const char* nA = has_next ? (const char*)g.A + (size_t)nxt.pm * tstep : cA; const char* nB = has_next ? (const char*)g.Bt + (size_t)nxt.pn * tstep : cB;
        for (int t = 0; t < nt; t += 2) {
            const bool last = (t == nt - 2);
            const char* a1 = cA + (size_t)(t + 1) * kstep;
            const char* a2 = last ? nA : cA + (size_t)(t + 2) * kstep; const char* b2 = last ? nB : cB + (size_t)(t + 2) * kstep;
            const char* a3 = a2 + kstep; const char* b3 = b2 + kstep;
            if (last && has_next) S.a_ready(nxt);
            if constexpr (SP2) {
            PG8_LDB(B0, 0, 0); PG8_LDB(B1, 0, 1); PG8_SCHED; PG8_LDA(At, 0, 0); PG8_STAGE(PG8_SA(1, 1), a1 + hstepA, voffA);
            PG8_WAIT_V(8); PG8_WAIT_L(0); PG8_BAR; PG8_MMA(0, 0, At, B0); PG8_MMA(0, 1, At, B1); PG8_BAR; PG8_SCHED;
            PG8_LDA(At, 0, 1); PG8_STAGE(PG8_SB(0, 0), b2, voffB); PG8_STAGE(PG8_SB(0, 1), b2 + hstepB, voffB); PG8_STAGE(PG8_SA(0, 0), a2, voffA);
            PG8_WAIT_V(8); PG8_WAIT_L(0); PG8_BAR; PG8_MMA(1, 0, At, B0); PG8_MMA(1, 1, At, B1); PG8_BAR; PG8_SCHED;
            PG8_LDB(B0, 1, 0); PG8_LDB(B1, 1, 1); PG8_SCHED; PG8_LDA(At, 1, 0); PG8_STAGE(PG8_SA(0, 1), a2 + hstepA, voffA);
            PG8_WAIT_V(8); PG8_WAIT_L(0); PG8_BAR; PG8_MMA(0, 0, At, B0); PG8_MMA(0, 1, At, B1); PG8_BAR; PG8_SCHED;
            PG8_LDA(At, 1, 1); PG8_STAGE(PG8_SB(1, 0), b3, voffB); PG8_STAGE(PG8_SB(1, 1), b3 + hstepB, voffB); PG8_STAGE(PG8_SA(1, 0), a3, voffA);
            PG8_WAIT_V(8); PG8_WAIT_L(0); PG8_BAR; PG8_MMA(1, 0, At, B0); PG8_MMA(1, 1, At, B1); PG8_BAR; PG8_SCHED;
            } else {
            PG8_LDB(B0, 0, 0); PG8_SCHED; PG8_LDA(At, 0, 0); PG8_STAGE(PG8_SA(1, 1), a1 + hstepA, voffA);
            PG8_WAIT_L(8); PG8_BAR; PG8_WAIT_L(0); PG8_MMA(0, 0, At, B0); PG8_BAR; PG8_SCHED;
            PG8_LDB(B1, 0, 1); PG8_STAGE(PG8_SB(0, 0), b2, voffB);
            PG8_BAR; PG8_WAIT_L(0); PG8_MMA(0, 1, At, B1); PG8_BAR;
            PG8_LDA(At, 0, 1); PG8_STAGE(PG8_SA(0, 0), a2, voffA);
            PG8_BAR; PG8_WAIT_L(0); PG8_MMA(1, 0, At, B0); PG8_BAR; PG8_SCHED;
            PG8_STAGE(PG8_SB(0, 1), b2 + hstepB, voffB);
            PG8_WAIT_V(6); PG8_BAR; PG8_MMA(1, 1, At, B1); PG8_BAR;
            PG8_LDB(B0, 1, 0); PG8_SCHED; PG8_LDA(At, 1, 0); PG8_STAGE(PG8_SA(0, 1), a2 + hstepA, voffA);
            PG8_WAIT_L(8); PG8_BAR; PG8_WAIT_L(0); PG8_MMA(0, 0, At, B0); PG8_BAR; PG8_SCHED;
            PG8_LDB(B1, 1, 1); PG8_STAGE(PG8_SB(1, 0), b3, voffB);
            PG8_BAR; PG8_WAIT_L(0); PG8_MMA(0, 1, At, B1); PG8_BAR;
            PG8_LDA(At, 1, 1); PG8_STAGE(PG8_SA(1, 0), a3, voffA);
            PG8_BAR; PG8_WAIT_L(0); PG8_MMA(1, 0, At, B0); PG8_BAR; PG8_SCHED;
            PG8_STAGE(PG8_SB(1, 1), b3 + hstepB, voffB);
            PG8_WAIT_V(6); PG8_BAR; PG8_MMA(1, 1, At, B1); PG8_BAR;
            }
        }
        if constexpr (ALIGN_EPI) { if (wr == 0) PG8_BAR; }
        if constexpr (!Epi::AFTER_DRAIN) { E(acc, cur, wr, wc, fr, fq); S.done(cur); }
        if (!has_next) break;
#pragma unroll
        for (int a = 0; a < 2; ++a)
#pragma unroll
            for (int b = 0; b < 2; ++b)
#pragma unroll
                for (int m = 0; m < 4; ++m)
#pragma unroll
                    for (int n = 0; n < 2; ++n) acc[a][b][m][n] = (f32x4){0.f, 0.f, 0.f, 0.f};
        cur = nxt; cA = nA; cB = nB; ++ui;
        if constexpr (ALIGN_EPI) { if (wr == 1) PG8_BAR; }
    }
    PG8_WAIT_V(0);
    if constexpr (!ALIGN_EPI) { if (wr == 0) PG8_BAR; }
    PG8_BAR;
    if constexpr (Epi::AFTER_DRAIN) { E.fused(acc, cur, wr, wc, fr, fq, lds, wid, lane); S.done(cur); }
#undef PG8_SA
#undef PG8_SB
#undef PG8_STAGE
#undef PG8_LDA
#undef PG8_LDB
#undef PG8_MMA
#undef PG8_WAIT_V
#undef PG8_WAIT_L
#undef PG8_BAR
#undef PG8_SCHED
}

}

constexpr size_t MiB = 1u << 20;
constexpr size_t WS_CTL = 0, CTL_ZERO_BYTES = 1 * MiB;
constexpr size_t WS_ROPE = 1 * MiB;
constexpr size_t WS_SAM = 1 * MiB + 256 * 1024;
constexpr size_t WS_SAH = 1 * MiB + 384 * 1024;
constexpr size_t WS_MOD = 1 * MiB + 512 * 1024;
constexpr size_t WS_KP = 2 * MiB;
constexpr size_t WS_BND = 3 * MiB;
constexpr size_t WS_W = 25 * MiB;
constexpr size_t W_IN = 0, W_OUT = 4 * MiB, W_UP = 6 * MiB, W_DOWN = 17 * MiB, W_LAYER = 22 * MiB + 512 * 1024;
constexpr size_t WS_H = 70 * MiB;
constexpr size_t WS_Y = 134 * MiB;
constexpr size_t WS_A = 198 * MiB;
constexpr size_t WS_Q = WS_A, WS_K = WS_A + 32 * MiB, WS_V = WS_A + 64 * MiB, WS_R = WS_A + 96 * MiB, WS_AO = WS_A + 128 * MiB, WS_MG = WS_A + 160 * MiB;
constexpr size_t WS_ACT = WS_A;
constexpr size_t WS_U = 422 * MiB;
constexpr size_t WS_X16 = 422 * MiB;
constexpr size_t WS_SEL = 490 * MiB;
constexpr size_t WS_END = 512 * MiB;
static_assert(WS_W + 2 * W_LAYER <= WS_H && WS_MG + 64 * MiB <= WS_U && WS_U + 44 * MiB <= WS_END, "d_ws map");
constexpr int CW_TMO = 0, CW_CODE = 1, CW_WFLAG = 64, CW_BAR = 4096;
constexpr int CW_CMAX = 131072, CMAX_LAYER = DM + 2 * 2816;

constexpr int RING_OFF = 0, RING_BYTES = 131072;
constexpr int LDSCTL_OFF = RING_BYTES, MISC_OFF = LDSCTL_OFF + 320;
constexpr int LDS_BYTES = 147456;
constexpr int EPI_LDS_OFF = LDSCTL_OFF + 2048;
constexpr int NWAVES = 8;

#define GAS __attribute__((address_space(1)))
#define LAS __attribute__((address_space(3)))
typedef unsigned short f16_t;
typedef unsigned v4u __attribute__((ext_vector_type(4)));
typedef unsigned v2u __attribute__((ext_vector_type(2)));
typedef float f32x4 __attribute__((ext_vector_type(4)));
typedef float f32x2 __attribute__((ext_vector_type(2)));
typedef _Float16 h16x2 __attribute__((ext_vector_type(2)));
typedef GAS unsigned gu32;
#define RLX_AGENT __ATOMIC_RELAXED, __HIP_MEMORY_SCOPE_AGENT
#define LDS_WAIT() asm volatile("s_waitcnt lgkmcnt(0)" ::: "memory")
#define VM_WAIT() asm volatile("s_waitcnt vmcnt(0)" ::: "memory")
__device__ __forceinline__ unsigned pkh(float lo, float hi) { return pg8::cvt_pk_f16(lo, hi); }
__device__ __forceinline__ f32x2 unpk(unsigned w) { const h16x2 h = __builtin_bit_cast(h16x2, w); return __builtin_convertvector(h, f32x2); }
__device__ __forceinline__ float h2f(f16_t h) { return (float)__builtin_bit_cast(_Float16, h); }
__device__ __forceinline__ f16_t f2h(float f) { return __builtin_bit_cast(f16_t, (_Float16)f); }
#define WS_DPP(v, ctrl) __builtin_bit_cast(float, __builtin_amdgcn_update_dpp(0, __builtin_bit_cast(int, (v)), (ctrl), 0xF, 0xF, true))
__device__ __forceinline__ float wave_sum(float v) {
    v += WS_DPP(v, 0xB1); v += WS_DPP(v, 0x4E); v += WS_DPP(v, 0x141); v += WS_DPP(v, 0x140);
    const int iv = __builtin_bit_cast(int, v);
    const float r0 = __builtin_bit_cast(float, __builtin_amdgcn_readlane(iv, 0)), r1 = __builtin_bit_cast(float, __builtin_amdgcn_readlane(iv, 16)),
                r2 = __builtin_bit_cast(float, __builtin_amdgcn_readlane(iv, 32)), r3 = __builtin_bit_cast(float, __builtin_amdgcn_readlane(iv, 48));
    return (r0 + r1) + (r2 + r3);
}
__device__ __forceinline__ float wave_max(float v) {
#pragma unroll
    for (int o = 1; o < 64; o <<= 1) v = fmaxf(v, __shfl_xor(v, o));
    return v;
}
__device__ __forceinline__ float rsq(float x) { return __builtin_amdgcn_rsqf(x); }
__device__ __forceinline__ float silu_f(float a) { return a * __builtin_amdgcn_rcpf(1.0f + __builtin_amdgcn_exp2f(-1.4426950408889634f * a)); }
namespace attn_body {
using f16=_Float16;
using h16x8=__attribute__((ext_vector_type(8)))_Float16;
using s16x8=__attribute__((ext_vector_type(8)))short;
using s16x4=__attribute__((ext_vector_type(4)))short;
using f32x16=__attribute__((ext_vector_type(16)))float;
using u32x4=__attribute__((ext_vector_type(4)))unsigned;
constexpr int BATCH=8,NHEAD=8,SEQ=4096,D=64,DM=NHEAD*D;
constexpr int NW=8,QBLK=32,QB=QBLK*NW,KVBLK=64,NQB=SEQ/QB;
constexpr int ATTN_PITCH=DM, ATTN_UNIT_ROWS=QB;
__device__ __forceinline__ int crow(int r,int hi){return (r&3)+8*(r>>2)+4*hi;}
#define SBAR() __builtin_amdgcn_sched_barrier(0)
__device__ __forceinline__ void cmask(f32x16&p0,f32x16&p1,int jb,int qrel,int hi){
  const float NEG=-INFINITY; int kb=64*jb+4*hi;
  #pragma unroll
  for(int r=0;r<16;++r){int kv=kb+(r&3)+8*(r>>2); if(kv>qrel)p0[r]=NEG; if(kv+32>qrel)p1[r]=NEG;}
}

constexpr int NSLOT=3, SLOTB=8192;
constexpr int LDS_K=0, LDS_V=NSLOT*SLOTB, LDS_WS=2*NSLOT*SLOTB, LDS_OST=LDS_WS+NW*64*4, LDS_BYTES=LDS_OST+NW*4096;
constexpr float C2=0.125f*1.4426950408889634f;
__device__ __forceinline__ void glds16(const void*gsrc,unsigned lds_dst){unsigned keep;
  asm volatile("s_mov_b32 %0, m0\n\ts_mov_b32 m0, %2\n\ts_nop 0\n\tglobal_load_lds_dwordx4 %1, off\n\ts_mov_b32 m0, %0":"=&s"(keep):"v"(gsrc),"s"(lds_dst):"memory");}
__device__ __forceinline__ float max3f(float a,float b,float c){float r;asm("v_max3_f32 %0, %1, %2, %3":"=v"(r):"v"(a),"v"(b),"v"(c));return r;}
__device__ __forceinline__ float max2f(float a,float b){float r;asm("v_max_f32_e32 %0, %1, %2":"=v"(r):"v"(a),"v"(b));return r;}
__device__ __forceinline__ float fadd_s(float a,float b){float r;asm("v_add_f32_e32 %0, %1, %2":"=v"(r):"v"(a),"v"(b));return r;}
__device__ __forceinline__ float fsub_s(float a,float b){float r;asm("v_sub_f32_e32 %0, %1, %2":"=v"(r):"v"(a),"v"(b));return r;}
typedef float f32x2_t __attribute__((ext_vector_type(2))); typedef _Float16 h16x2_t __attribute__((ext_vector_type(2)));
__device__ __forceinline__ unsigned cvtpk_s(float lo,float hi){f32x2_t v={lo,hi};h16x2_t b=__builtin_convertvector(v,h16x2_t);return __builtin_bit_cast(unsigned,b);}
#define WAIT_BAR(N) asm volatile("s_waitcnt vmcnt(" #N ") lgkmcnt(0)\n\ts_barrier":::"memory")

__device__ __forceinline__ void qkt(f32x16&p0,f32x16&p1,const char*Kslot,const h16x8*qr,const f32x16&negm,int r32,int hi){
  const char*kb=Kslot+hi*1024+r32*16;
  #pragma unroll
  for(int d0=0;d0<4;++d0){
    const h16x8 b0=*reinterpret_cast<const h16x8*>(kb+d0*2048);
    const h16x8 b1=*reinterpret_cast<const h16x8*>(kb+d0*2048+512);
    if(d0==0){p0=__builtin_amdgcn_mfma_f32_32x32x16_f16(b0,qr[0],negm,0,0,0);p1=__builtin_amdgcn_mfma_f32_32x32x16_f16(b1,qr[0],negm,0,0,0);}
    else{p0=__builtin_amdgcn_mfma_f32_32x32x16_f16(b0,qr[d0],p0,0,0,0);p1=__builtin_amdgcn_mfma_f32_32x32x16_f16(b1,qr[d0],p1,0,0,0);}}
}
typedef __attribute__((address_space(3))) const char* lds_cptr;
typedef short v4i16_t __attribute__((ext_vector_type(4)));
__device__ __forceinline__ void kload8(h16x8*kf,lds_cptr kp){
  kf[0]=*(const __attribute__((address_space(3))) h16x8*)(kp);      kf[1]=*(const __attribute__((address_space(3))) h16x8*)(kp+512);
  kf[2]=*(const __attribute__((address_space(3))) h16x8*)(kp+2048); kf[3]=*(const __attribute__((address_space(3))) h16x8*)(kp+2560);
  kf[4]=*(const __attribute__((address_space(3))) h16x8*)(kp+4096); kf[5]=*(const __attribute__((address_space(3))) h16x8*)(kp+4608);
  kf[6]=*(const __attribute__((address_space(3))) h16x8*)(kp+6144); kf[7]=*(const __attribute__((address_space(3))) h16x8*)(kp+6656);
}
__device__ __forceinline__ void kload2(h16x8*kf,lds_cptr kp,int j){ kf[2*j]=*(const __attribute__((address_space(3))) h16x8*)(kp+j*2048); kf[2*j+1]=*(const __attribute__((address_space(3))) h16x8*)(kp+j*2048+512); }
__device__ __forceinline__ s16x4 vtr(lds_cptr p){ return __builtin_bit_cast(s16x4,__builtin_amdgcn_ds_read_tr16_b64_v4i16((__attribute__((address_space(3))) v4i16_t*)p)); }
__device__ __forceinline__ float rowmax(const f32x16&p0,const f32x16&p1){
  float a=max3f(p0[0],p0[1],p1[0]),b=max3f(p0[2],p0[3],p1[1]);a=max3f(a,p1[2],p1[3]);
  #pragma unroll
  for(int r=4;r<16;r+=4){a=max3f(a,p0[r],p0[r+1]);b=max3f(b,p0[r+2],p0[r+3]);a=max3f(a,p1[r],p1[r+1]);b=max3f(b,p1[r+2],p1[r+3]);}
  const float m=max2f(a,b);
  auto rr=__builtin_amdgcn_permlane32_swap(__float_as_uint(m),__float_as_uint(m),false,false);
  return max2f(__uint_as_float(rr[0]),__uint_as_float(rr[1]));
}
__device__ __forceinline__ void pv(f32x16*o,int vb,h16x8 pa0,h16x8 pa1,h16x8 pa2,h16x8 pa3){
  #pragma unroll
  for(int d0=0;d0<2;++d0){s16x4 lo[4],hi[4];
    #pragma unroll
    for(int ks=0;ks<4;++ks){
      asm volatile("ds_read_b64_tr_b16 %0,%1 offset:%c2":"=&v"(lo[ks]):"v"(vb),"i"(d0*4096+ks*1024):"memory");
      asm volatile("ds_read_b64_tr_b16 %0,%1 offset:%c2":"=&v"(hi[ks]):"v"(vb),"i"(d0*4096+ks*1024+512):"memory");}
    asm volatile("s_waitcnt lgkmcnt(0)":::"memory");SBAR();
    #define PK(k) __builtin_bit_cast(h16x8,(s16x8){lo[k][0],lo[k][1],lo[k][2],lo[k][3],hi[k][0],hi[k][1],hi[k][2],hi[k][3]})
    o[d0]=__builtin_amdgcn_mfma_f32_32x32x16_f16(pa0,PK(0),o[d0],0,0,0);
    o[d0]=__builtin_amdgcn_mfma_f32_32x32x16_f16(pa1,PK(1),o[d0],0,0,0);
    o[d0]=__builtin_amdgcn_mfma_f32_32x32x16_f16(pa2,PK(2),o[d0],0,0,0);
    o[d0]=__builtin_amdgcn_mfma_f32_32x32x16_f16(pa3,PK(3),o[d0],0,0,0);
    #undef PK
  }
}

#ifndef ATTN_STORE16
#define ATTN_STORE16(p,v) (*(u32x4*)(p)=(v))
#endif
template<int THRL> __device__ __forceinline__ void attn_unit(int b,int h,int qb,const f16*Q,const f16*__restrict__ K,const f16*__restrict__ V,f16*O,const unsigned*__restrict__ SEL,char*shm){
  const int tid=hw_tid(),lane=tid&63,r32=lane&31,hi=lane>>5; const int wid=__builtin_amdgcn_readfirstlane(tid>>6);
  const long rowbase=(long)b*SEQ; const int q0=qb*QB;
  const f16*Qw=Q+(rowbase+q0+wid*QBLK)*DM+h*D;
  const f16*Kh=K+rowbase*DM+h*D,*Vh=V+rowbase*DM+h*D;
  const unsigned lds0=(unsigned)(uintptr_t)shm;
  float*wsf=(float*)(shm+LDS_WS)+wid*64;
  const f16*ksrc=Kh+(long)lane*DM+wid*8;
  const f16*vsrc=Vh+(long)(16*(wid&3)+(lane>>2))*DM+(wid>>2)*32+(lane&3)*8;
  const unsigned kdst=lds0+LDS_K+wid*1024, vdst=lds0+LDS_V+wid*1024;
  #define TILE(t) (((t)==0)?(NT-4):(((t)<=NT-4)?((t)-1):(t)))
  #define DMA_K(t,slot) glds16(ksrc+(long)TILE(t)*KVBLK*DM,(unsigned)__builtin_amdgcn_readfirstlane(kdst+(slot)))
  #define DMA_V(t,slot) glds16(vsrc+(long)TILE(t)*KVBLK*DM,(unsigned)__builtin_amdgcn_readfirstlane(vdst+(slot)))
  const int vb0=(int)(lds0+LDS_V)+((lane>>4)&1)*32+(lane&3)*8+(4*hi+((lane&15)>>2))*64;
  const char*Kbase=shm+LDS_K; h16x8 kf[8];
  const lds_cptr shm3=(lds_cptr)shm; const lds_cptr kp0=shm3+LDS_K+hi*1024+r32*16; const lds_cptr vp0=shm3+LDS_V+((lane>>4)&1)*32+(lane&3)*8+(4*hi+((lane&15)>>2))*64;
  const int NT=(q0+QB)/KVBLK;
  DMA_K(0,0);DMA_V(0,0);DMA_K(1,SLOTB);
  h16x8 qr[4];
  #pragma unroll
  for(int d0=0;d0<4;++d0)qr[d0]=*reinterpret_cast<const h16x8*>(&Qw[(long)r32*DM+d0*16+hi*8]);
  float mhat=0.f,l_reg=0.f;f32x16 o[2];o[0]=f32x16{};o[1]=f32x16{};f32x16 negm=f32x16{};asm volatile("":"+v"(negm));
  const int qrel=wid*QBLK+r32;
  const unsigned selmask=SEL[(rowbase+q0+qrel)*NHEAD+h];
  #define NEGM_SET(tn) do{ const bool nx_=((tn)>=NT-3)||(((selmask>>((((tn)-1)>>2)&15))&1u)!=0u); const float nv_=nx_?-mhat:-INFINITY; _Pragma("unroll") for(int r=0;r<16;++r)negm[r]=nv_; asm volatile("":"+v"(negm)); }while(0)
  #define CMASK(P0,P1,t) do{int jb_=(t)-(NT-4); if(jb_>=1)cmask(P0,P1,jb_,qrel,hi);}while(0)
  bool resc=false;
  #define START(P0,P1) do{ const float rm=rowmax(P0,P1); resc=false; \
    { const float dl=rm; mhat=fadd_s(mhat,dl); \
      _Pragma("unroll") for(int r=0;r<16;++r){P0[r]=fsub_s(P0[r],dl);P1[r]=fsub_s(P1[r],dl);} \
      NEGM_SET(1); } \
    _Pragma("unroll") for(int r=0;r<16;++r)P0[r]=__builtin_amdgcn_exp2f(P0[r]); }while(0)
  #define RESC() do{ if(resc){ asm volatile("s_waitcnt lgkmcnt(0)":::"memory"); \
      _Pragma("unroll") for(int d_=0;d_<2;++d_) _Pragma("unroll") for(int r=0;r<16;++r)o[d_][r]*=wsf[crow(r,hi)]; } }while(0)
  f32x16 pA0,pA1,pB0,pB1;
  int sl_prev=0,sl_cur=0,sl_next=SLOTB;
  #define ROT() do{sl_prev=sl_cur;sl_cur=sl_next;sl_next=(sl_next==(NSLOT-1)*SLOTB)?0:sl_next+SLOTB;}while(0)
  DMA_K(2,2*SLOTB);
  WAIT_BAR(3);
  qkt(pA0,pA1,Kbase,qr,negm,r32,hi);asm volatile("s_nop 15\n\ts_nop 7":"+v"(pA0),"+v"(pA1));cmask(pA0,pA1,0,qrel,hi);
  START(pA0,pA1);
  _Pragma("unroll") for(int r=0;r<16;++r)pA1[r]=__builtin_amdgcn_exp2f(pA1[r]);
  WAIT_BAR(0);
  DMA_K(3,0);DMA_V(1,SLOTB);
  ROT();
  kload8(kf,kp0+sl_cur);
  WAIT_BAR(2);
  s16x4 vlo[8],vhi[8]; u32x4 pw0,pw1,pw2,pw3;
  #define PKW(P,B) cvtpk_s(P[B],P[B+1])
  #define PAF(k) __builtin_bit_cast(h16x8,pw##k)
  #define VFR(i) __builtin_bit_cast(h16x8,(s16x8){vlo[i][0],vlo[i][1],vlo[i][2],vlo[i][3],vhi[i][0],vhi[i][1],vhi[i][2],vhi[i][3]})
  #define PIN(x) asm volatile("":"+v"(x))
  #define MX3(a,b,c) __builtin_fmaxf(__builtin_fmaxf((a),(b)),(c))
  #define GAPA(MF,A0,A1,A2,A3,W0,W1,PW) do{ MF; sacc+=A0; sacc+=A1; sacc+=A2; sacc+=A3; PIN(sacc); W0; W1; PIN(PW); SBAR(); }while(0)
  #define EX(v) __builtin_amdgcn_exp2f(v)
  #define GAPB(MF,X,B) do{ MF; X[B]=EX(X[B]); X[B+1]=EX(X[B+1]); X[B+2]=EX(X[B+2]); X[B+3]=EX(X[B+3]); PIN(X); SBAR(); }while(0)
  #define VRD(i) do{ vlo[i]=vtr(vp_+(((i)>>2)*4096+((i)&3)*1024)); vhi[i]=vtr(vp_+(((i)>>2)*4096+((i)&3)*1024+512)); }while(0)
  #define KRD(G,j) do{ if(G){ kload2(kf,kp0+sl_next,j); SBAR(); } }while(0)
  #define STEP(C0,C1,P0,P1,t,GK,GV,GL) do{ SBAR(); \
    const lds_cptr vp_=vp0+sl_prev; \
    VRD(0); SBAR(); float sacc=(P0[0]+P0[1]); \
    GAPA(C0=__builtin_amdgcn_mfma_f32_32x32x16_f16(kf[0],qr[0],negm,0,0,0), P0[2],P0[3],P0[4],P0[5],     pw0[0]=PKW(P0,0), pw0[1]=PKW(P0,2), pw0); \
    VRD(4); SBAR(); GAPA(C1=__builtin_amdgcn_mfma_f32_32x32x16_f16(kf[1],qr[0],negm,0,0,0), P0[6],P0[7],P0[8],P0[9],     pw0[2]=PKW(P0,4), pw0[3]=PKW(P0,6), pw0); \
    VRD(1); SBAR(); GAPA(C0=__builtin_amdgcn_mfma_f32_32x32x16_f16(kf[2],qr[1],C0,0,0,0),   P0[10],P0[11],P0[12],P0[13], pw1[0]=PKW(P0,8), pw1[1]=PKW(P0,10), pw1); \
    VRD(5); SBAR(); GAPA(C1=__builtin_amdgcn_mfma_f32_32x32x16_f16(kf[3],qr[1],C1,0,0,0),   P0[14],P0[15],P1[0],P1[1],   pw1[2]=PKW(P0,12),pw1[3]=PKW(P0,14), pw1); \
    VRD(2); SBAR(); GAPA(C0=__builtin_amdgcn_mfma_f32_32x32x16_f16(kf[4],qr[2],C0,0,0,0),   P1[2],P1[3],P1[4],P1[5],     pw2[0]=PKW(P1,0), pw2[1]=PKW(P1,2), pw2); \
    VRD(6); SBAR(); GAPA(C1=__builtin_amdgcn_mfma_f32_32x32x16_f16(kf[5],qr[2],C1,0,0,0),   P1[6],P1[7],P1[8],P1[9],     pw2[2]=PKW(P1,4), pw2[3]=PKW(P1,6), pw2); \
    VRD(3); SBAR(); GAPA(C0=__builtin_amdgcn_mfma_f32_32x32x16_f16(kf[6],qr[3],C0,0,0,0),   P1[10],P1[11],P1[12],P1[13], pw3[0]=PKW(P1,8), pw3[1]=PKW(P1,10), pw3); \
    VRD(7); SBAR(); GAPA(C1=__builtin_amdgcn_mfma_f32_32x32x16_f16(kf[7],qr[3],C1,0,0,0),   P1[14],P1[15],0.f,0.f,       pw3[2]=PKW(P1,12),pw3[3]=PKW(P1,14), pw3); \
    l_reg+=sacc; \
    if(GK){DMA_K((t)+3,sl_cur);} if(GV){DMA_V((t)+1,sl_next);} \
    CMASK(C0,C1,t); \
    { float a=MX3(C0[0],C0[1],C1[0]),b=MX3(C0[2],C0[3],C1[1]); a=MX3(a,C1[2],C1[3]); \
      _Pragma("unroll") for(int r=4;r<16;r+=4){a=MX3(a,C0[r],C0[r+1]);b=MX3(b,C0[r+2],C0[r+3]);a=MX3(a,C1[r],C1[r+1]);b=MX3(b,C1[r+2],C1[r+3]);} \
      float rm=__builtin_fmaxf(a,b); { auto rr=__builtin_amdgcn_permlane32_swap(__float_as_uint(rm),__float_as_uint(rm),false,false); rm=__builtin_fmaxf(__uint_as_float(rr[0]),__uint_as_float(rr[1])); } \
      resc=false; \
      if(__builtin_expect(__any(rm>(float)THRL),0)){ const float dl=__builtin_fmaxf(rm,0.f); mhat+=dl; \
        _Pragma("unroll") for(int r=0;r<16;++r){C0[r]-=dl;C1[r]-=dl;} \
        const float f=__builtin_amdgcn_exp2f(-dl); l_reg*=f; if(hi==0)wsf[r32]=f; resc=true; } \
      if(resc||(((t)&3)==0)||((t)+4>=NT)){ NEGM_SET((t)+1); } } \
    SBAR(); \
    GAPB(o[0]=__builtin_amdgcn_mfma_f32_32x32x16_f16(PAF(0),VFR(0),o[0],0,0,0), C0,0); \
    GAPB(o[1]=__builtin_amdgcn_mfma_f32_32x32x16_f16(PAF(0),VFR(4),o[1],0,0,0), C0,4); \
    KRD(GL,0); GAPB(o[0]=__builtin_amdgcn_mfma_f32_32x32x16_f16(PAF(1),VFR(1),o[0],0,0,0), C0,8); \
    KRD(GL,1); GAPB(o[1]=__builtin_amdgcn_mfma_f32_32x32x16_f16(PAF(1),VFR(5),o[1],0,0,0), C0,12); \
    KRD(GL,2); GAPB(o[0]=__builtin_amdgcn_mfma_f32_32x32x16_f16(PAF(2),VFR(2),o[0],0,0,0), C1,0); \
    KRD(GL,3); GAPB(o[1]=__builtin_amdgcn_mfma_f32_32x32x16_f16(PAF(2),VFR(6),o[1],0,0,0), C1,4); \
    GAPB(o[0]=__builtin_amdgcn_mfma_f32_32x32x16_f16(PAF(3),VFR(3),o[0],0,0,0), C1,8); \
    GAPB(o[1]=__builtin_amdgcn_mfma_f32_32x32x16_f16(PAF(3),VFR(7),o[1],0,0,0), C1,12); \
    }while(0)
  int t=1;
  #undef CMASK
  #define CMASK(P0,P1,t) do{}while(0)
  for(;t+5<NT;t+=2){
    STEP(pB0,pB1,pA0,pA1,t,true,true,true);     WAIT_BAR(2); RESC(); ROT();
    STEP(pA0,pA1,pB0,pB1,t+1,true,true,true);   WAIT_BAR(2); RESC(); ROT();
  }
  #undef CMASK
  #define CMASK(P0,P1,t) do{int jb_=(t)-(NT-4); if(jb_>=1)cmask(P0,P1,jb_,qrel,hi);}while(0)
  #define ENDW(tt) do{ if((tt)+3<NT){WAIT_BAR(2);} else if((tt)+2<NT){WAIT_BAR(1);} else {WAIT_BAR(0);} }while(0)
  for(;t+1<NT;t+=2){
    STEP(pB0,pB1,pA0,pA1,t,(t+3<NT),(t+1<NT),(t+1<NT));       ENDW(t);   RESC(); ROT();
    STEP(pA0,pA1,pB0,pB1,t+1,(t+4<NT),(t+2<NT),(t+2<NT));     ENDW(t+1); RESC(); ROT();
  }
  STEP(pB0,pB1,pA0,pA1,NT-1,false,false,false); RESC();
  { float sacc=pB0[0]+pB0[1]; _Pragma("unroll") for(int r=2;r<16;++r)sacc+=pB0[r]; _Pragma("unroll") for(int r=0;r<16;++r)sacc+=pB1[r]; l_reg+=sacc;
    pw0=(u32x4){PKW(pB0,0),PKW(pB0,2),PKW(pB0,4),PKW(pB0,6)};pw1=(u32x4){PKW(pB0,8),PKW(pB0,10),PKW(pB0,12),PKW(pB0,14)};pw2=(u32x4){PKW(pB1,0),PKW(pB1,2),PKW(pB1,4),PKW(pB1,6)};pw3=(u32x4){PKW(pB1,8),PKW(pB1,10),PKW(pB1,12),PKW(pB1,14)};
    SBAR(); pv(o,vb0+sl_cur,PAF(0),PAF(1),PAF(2),PAF(3)); }
  #undef PKW
  #undef PAF
  #undef VFR
  #undef PIN
  #undef MX3
  #undef GAPA
  #undef GAPB
  #undef EX
  #undef VRD
  #undef KRD
  #undef STEP
  #undef ENDW
  {auto rr=__builtin_amdgcn_permlane32_swap(__float_as_uint(l_reg),__float_as_uint(l_reg),false,false);l_reg=__uint_as_float(rr[0])+__uint_as_float(rr[1]);}
  if(hi==0)wsf[32+r32]=l_reg;asm volatile("s_waitcnt lgkmcnt(0)":::"memory");
  float rli[16];
  #pragma unroll
  for(int r=0;r<16;++r)rli[r]=__builtin_amdgcn_rcpf(wsf[32+crow(r,hi)]);
  f16*Ow=O+(rowbase+q0+wid*QBLK)*DM+h*D;
  { f16*stg=(f16*)(shm+LDS_OST)+wid*2048;
    #pragma unroll
    for(int r=0;r<16;++r){const int orow=crow(r,hi);
      #pragma unroll
      for(int d0=0;d0<2;++d0)stg[orow*64+d0*32+r32]=(f16)(o[d0][r]*rli[r]);}
    asm volatile("s_waitcnt lgkmcnt(0)":::"memory");
    #pragma unroll
    for(int i=0;i<4;++i){const int row=i*8+(lane>>3),ch=lane&7; const u32x4 v=*(const u32x4*)(stg+row*64+ch*8); ATTN_STORE16(Ow+(long)row*DM+ch*8,v);} }
  asm volatile("s_waitcnt lgkmcnt(0)\n\ts_barrier":::"memory");
  #undef DMA_K
  #undef TILE
  #undef NEGM_SET
  #undef DMA_V
  #undef CMASK
  #undef START
  #undef RESC
  #undef ROT
}
constexpr int ATTN_LDS_BYTES=LDS_BYTES;
struct AttnTensors { const f16* Q; const f16* K; const f16* V; f16* O; const unsigned* SEL; };
struct AttnUnit { int bh; int qb; };
struct StaticOrder {
  int vcu;
  __device__ __forceinline__ explicit StaticOrder(int grid,int block):vcu((block%8)*(grid/8)+block/8){}
  __device__ __forceinline__ bool next(int i,AttnUnit&u)const{ if(i>=4)return false; const int s=vcu&3; u.bh=vcu>>2; u.qb=(i==0)?15-s:(i==1)?8+s:(i==2)?7-s:s; return true; }
  __device__ __forceinline__ void a_ready(const AttnUnit&)const{}
  __device__ __forceinline__ void done(const AttnUnit&)const{}
};
template<class Sched,int THRL=8> __device__ __forceinline__ void attn_phase(char*lds,const AttnTensors&T,const Sched&S){
  AttnUnit u;
  for(int i=0;S.next(i,u);++i){ S.a_ready(u); attn_unit<THRL>(u.bh/NHEAD,u.bh%NHEAD,u.qb,T.Q,T.K,T.V,T.O,T.SEL,lds); S.done(u); }
}
#undef SBAR
#undef WAIT_BAR
}
#define XB_TMO      128
#define XB_XCNT(j)  (256  + 64 * (j))
#define XB_XSUB(j)  (1280 + 64 * (j))
#define XB_XGEN(j)  (2304 + 64 * (j))
#define XB_TOP      3328
#define XB_TOPGEN   3392
#define XCD_BAR_WORDS 3456
#define XB_SPIN_CAP (1u << 18)

__device__ __forceinline__ unsigned xb_ld(unsigned* p)              { return __hip_atomic_load(p, __ATOMIC_RELAXED, __HIP_MEMORY_SCOPE_AGENT); }
__device__ __forceinline__ unsigned xb_add(unsigned* p, unsigned v) { return __hip_atomic_fetch_add(p, v, __ATOMIC_RELAXED, __HIP_MEMORY_SCOPE_AGENT); }
__device__ __forceinline__ unsigned xb_xcc_id() { return (unsigned)__builtin_amdgcn_s_getreg((3 << 11) | 20) & 0xFu; }
#define XB_SPIN(cond, bar) do { unsigned _sp = 0; while (cond) { __builtin_amdgcn_s_sleep(1); \
    if ((++_sp & 255u) == 0u) { if (xb_ld(&(bar)[XB_TMO])) break; if (_sp > XB_SPIN_CAP) { atomicAdd(&(bar)[XB_TMO], 1u); break; } } } } while (0)

struct XcdBarrier {
    unsigned* bar; unsigned x; unsigned gsize;
    volatile LAS unsigned* st;
};

__device__ __forceinline__ XcdBarrier xcd_barrier_post(unsigned* bar, volatile LAS unsigned* st, unsigned gsize) {
    XcdBarrier b; b.bar = bar; b.x = xb_xcc_id(); b.st = st; b.gsize = gsize;
    if (hw_tid() == 0) (void)xb_add(&bar[XB_XCNT(b.x)], 1u);
    return b;
}
__device__ __forceinline__ void xcd_barrier_complete(unsigned* bar, unsigned x, unsigned G, unsigned& nloc, unsigned& nx) {
    unsigned sum, cnt, mine, sp = 0u;
    for (;;) {
        sum = 0u; cnt = 0u; mine = 0u;
#pragma unroll
        for (unsigned j = 0; j < 16; ++j) { const unsigned c = xb_ld(&bar[XB_XCNT(j)]); sum += c; cnt += (c > 0u) ? 1u : 0u; mine = (j == x) ? c : mine; }
        if (sum == G) break;
        __builtin_amdgcn_s_sleep(1);
        if ((++sp & 255u) == 0u) { if (xb_ld(&bar[XB_TMO])) break; if (sp > XB_SPIN_CAP) { atomicAdd(&bar[XB_TMO], 1u); break; } }
    }
    nloc = mine > 0u ? mine : 1u; nx = cnt > 0u ? cnt : 1u;
}

__device__ __forceinline__ void xcd_barrier(const XcdBarrier& b) {
    asm volatile("s_waitcnt vmcnt(0)" ::: "memory");
    __syncthreads();
    if (hw_tid() == 0) {
        unsigned* bar = b.bar;
        __builtin_amdgcn_s_waitcnt(0);
        unsigned nloc = b.st[0], nx = b.st[1];
        if (nloc == 0u) { xcd_barrier_complete(bar, b.x, b.gsize, nloc, nx); b.st[0] = nloc; b.st[1] = nx; }
        const unsigned old = xb_add(&bar[XB_XSUB(b.x)], 1u);
        const unsigned gen = old / nloc;
        if (old + 1u == (gen + 1u) * nloc) {
            __builtin_amdgcn_fence(__ATOMIC_RELEASE, "agent");
            asm volatile("s_waitcnt vmcnt(0)" ::: "memory");
            const unsigned og = xb_add(&bar[XB_TOP], 1u);
            const unsigned tg = og / nx;
            if (og + 1u == (tg + 1u) * nx) xb_add(&bar[XB_TOPGEN], 1u);
            else XB_SPIN(xb_ld(&bar[XB_TOPGEN]) == tg, bar);
            __builtin_amdgcn_fence(__ATOMIC_ACQUIRE, "agent");
            xb_add(&bar[XB_XGEN(b.x)], 1u);
            asm volatile("s_waitcnt vmcnt(0)" ::: "memory");
        } else {
            XB_SPIN(xb_ld(&bar[XB_XGEN(b.x)]) == gen, bar);
            __builtin_amdgcn_fence(__ATOMIC_ACQUIRE, "agent");
            asm volatile("s_waitcnt vmcnt(0)" ::: "memory");
        }
    }
    __syncthreads();
}

struct Args {
    const float* x; const float* c; const float* w_ada; const float* b_ada; const float* g_pre_mix; const float* w_in; const float* w_pool; const float* pool_scale;
    const float* attn_out_gain; const float* pool_out_gain; const float* w_out; const float* g_post_mix; const float* g_pre_ffn; const float* w_up; const float* conv_w;
    const float* conv_b; const float* w_down; const float* g_post_ffn;
    float* out; unsigned char* ws;
    int ph_lo, ph_hi, li, chunk;
};

constexpr int ARGS_OFF = LDSCTL_OFF + 1024;
__device__ __forceinline__ const void* lds_ptr(LAS unsigned char* lds, int i) { const unsigned long long v = ((const LAS unsigned long long*)(lds + ARGS_OFF))[i];
    const unsigned lo = __builtin_amdgcn_readfirstlane((unsigned)v), hi = __builtin_amdgcn_readfirstlane((unsigned)(v >> 32)); return (const void*)(const GAS void*)(((unsigned long long)hi << 32) | lo); }
__device__ __forceinline__ Args lds_args(LAS unsigned char* lds) { Args a{};
    a.x = (const float*)lds_ptr(lds, 0); a.c = (const float*)lds_ptr(lds, 1); a.w_ada = (const float*)lds_ptr(lds, 2); a.b_ada = (const float*)lds_ptr(lds, 3); a.g_pre_mix = (const float*)lds_ptr(lds, 4);
    a.w_in = (const float*)lds_ptr(lds, 5); a.w_pool = (const float*)lds_ptr(lds, 6); a.pool_scale = (const float*)lds_ptr(lds, 7); a.attn_out_gain = (const float*)lds_ptr(lds, 8); a.pool_out_gain = (const float*)lds_ptr(lds, 9);
    a.w_out = (const float*)lds_ptr(lds, 10); a.g_post_mix = (const float*)lds_ptr(lds, 11); a.g_pre_ffn = (const float*)lds_ptr(lds, 12); a.w_up = (const float*)lds_ptr(lds, 13); a.conv_w = (const float*)lds_ptr(lds, 14);
    a.conv_b = (const float*)lds_ptr(lds, 15); a.w_down = (const float*)lds_ptr(lds, 16); a.g_post_ffn = (const float*)lds_ptr(lds, 17); a.out = (float*)lds_ptr(lds, 18); a.ws = (unsigned char*)lds_ptr(lds, 19);
    return a; }

constexpr int PH_PRO = 0, PH_PRO2 = 1, PH_PRE = 2, PH_L0 = 3;
constexpr int J_G1 = 0;
constexpr int J_GATE = 1;
constexpr int J_ATT = J_GATE + 1;
constexpr int J_MERGE = J_ATT + 1, J_G2 = J_ATT + 2, J_POST1 = J_ATT + 3, J_G3 = J_ATT + 4, J_FIX = J_ATT + 5, J_G4 = J_ATT + 6, J_POST2 = J_ATT + 7, NPL = J_ATT + 8;
constexpr int NPH = PH_L0 + DEPTH * NPL;

__device__ __forceinline__ void transpose_item(const float* W, int K, int N, f16_t* WT, int k0, int n0, int drow0, LAS float* scr, int lane) {
    float wv[32];
#pragma unroll
    for (int i = 0; i < 32; ++i) { const int kk = 2 * i + (lane >> 5); wv[i] = W[(size_t)(k0 + kk) * N + n0 + (lane & 31)]; }
#pragma unroll
    for (int i = 0; i < 32; ++i) { const int kk = 2 * i + (lane >> 5); scr[kk * 33 + (lane & 31)] = wv[i]; }
    LDS_WAIT(); asm volatile("" ::: "memory");
    const int c = lane & 7;
#pragma unroll
    for (int j = 0; j < 4; ++j) { const int n = (lane >> 3) + 8 * j; const LAS float* s = scr + (8 * c) * 33 + n;
        v4u o; o.x = pkh(s[0 * 33], s[1 * 33]); o.y = pkh(s[2 * 33], s[3 * 33]); o.z = pkh(s[4 * 33], s[5 * 33]); o.w = pkh(s[6 * 33], s[7 * 33]);
        *(v4u*)(WT + (size_t)(drow0 + n) * K + k0 + 8 * c) = o; }
    LDS_WAIT(); asm volatile("" ::: "memory");
}
__device__ __forceinline__ void transpose_item_f8(const float* W, int K, int N, unsigned char* WT, int k0, int n0, int drow0, float scale, LAS float* scr, int lane) {
    float wv[32];
#pragma unroll
    for (int i = 0; i < 32; ++i) { const int kk = 2 * i + (lane >> 5); wv[i] = W[(size_t)(k0 + kk) * N + n0 + (lane & 31)]; }
#pragma unroll
    for (int i = 0; i < 32; ++i) { const int kk = 2 * i + (lane >> 5); scr[kk * 33 + (lane & 31)] = wv[i] * scale; }
    LDS_WAIT(); asm volatile("" ::: "memory");
    const int c = lane & 7;
#pragma unroll
    for (int j = 0; j < 4; ++j) { const int n = (lane >> 3) + 8 * j; const LAS float* s = scr + (8 * c) * 33 + n;
        v2u o; o.x = pg8::pk4_fp8(s[0 * 33], s[1 * 33], s[2 * 33], s[3 * 33]); o.y = pg8::pk4_fp8(s[4 * 33], s[5 * 33], s[6 * 33], s[7 * 33]);
        *(v2u*)(WT + (size_t)(drow0 + n) * K + k0 + 8 * c) = o; }
    LDS_WAIT(); asm volatile("" ::: "memory");
}
__device__ __forceinline__ unsigned pk4_i8(float a, float b, float c, float d) {
    const int ia = (int)__builtin_rintf(a), ib = (int)__builtin_rintf(b), ic = (int)__builtin_rintf(c), id = (int)__builtin_rintf(d);
    return ((unsigned)ia & 255u) | (((unsigned)ib & 255u) << 8) | (((unsigned)ic & 255u) << 16) | ((unsigned)id << 24); }
__device__ __forceinline__ v2u pk8_i8(const float (&v)[8], float inv) { v2u w; w.x = pk4_i8(v[0] * inv, v[1] * inv, v[2] * inv, v[3] * inv); w.y = pk4_i8(v[4] * inv, v[5] * inv, v[6] * inv, v[7] * inv); return w; }
__device__ __forceinline__ void colmax_item(const float* W, int N, float* cmax, int k0, int n0, int lane) {
    float wv[32];
#pragma unroll
    for (int i = 0; i < 32; ++i) { const int kk = 2 * i + (lane >> 5); wv[i] = W[(size_t)(k0 + kk) * N + n0 + (lane & 31)]; }
    float m = 0.f;
#pragma unroll
    for (int i = 0; i < 32; ++i) m = fmaxf(m, fabsf(wv[i]));
    m = fmaxf(m, __shfl_xor(m, 32));
    if (lane < 32) __hip_atomic_fetch_max((unsigned*)(cmax + n0 + lane), __builtin_bit_cast(unsigned, m), __ATOMIC_RELAXED, __HIP_MEMORY_SCOPE_AGENT);
}
__device__ __forceinline__ void transpose_item_i8(const float* W, int K, int N, unsigned char* WT, int k0, int n0, int drow0, const float* cmax, LAS float* scr, int lane) {
    float wv[32];
#pragma unroll
    for (int i = 0; i < 32; ++i) { const int kk = 2 * i + (lane >> 5); wv[i] = W[(size_t)(k0 + kk) * N + n0 + (lane & 31)]; }
    const float inv = 127.0f / fmaxf(cmax[n0 + (lane & 31)], 1e-30f);
#pragma unroll
    for (int i = 0; i < 32; ++i) { const int kk = 2 * i + (lane >> 5); scr[kk * 33 + (lane & 31)] = wv[i] * inv; }
    LDS_WAIT(); asm volatile("" ::: "memory");
    const int c = lane & 7;
#pragma unroll
    for (int j = 0; j < 4; ++j) { const int n = (lane >> 3) + 8 * j; const LAS float* sp = scr + (8 * c) * 33 + n;
        v2u o; o.x = pk4_i8(sp[0 * 33], sp[1 * 33], sp[2 * 33], sp[3 * 33]); o.y = pk4_i8(sp[4 * 33], sp[5 * 33], sp[6 * 33], sp[7 * 33]);
        *(v2u*)(WT + (size_t)(drow0 + n) * K + k0 + 8 * c) = o; }
    LDS_WAIT(); asm volatile("" ::: "memory");
}
__device__ __forceinline__ int up_row(int n) {
    const int bj = n / FF, rem = n - bj * FF; return 256 * (rem >> 7) + 128 * bj + (rem & 127);
}
constexpr int NIN_COLS = 1536;
constexpr int IT_IN = 16 * (NIN_COLS / 32), IT_OUT = 16 * 32, IT_UP = 16 * (FF2 / 32), IT_DOWN = (FF / 64) * 32, IT_LAYER = IT_IN + IT_OUT + IT_UP + IT_DOWN;

#define AP(i) ((const float*)lds_ptr(lds, (i)))
template <int PART> __device__ __forceinline__ void ph_prologue(LAS unsigned char* lds, int tid, int lane, int wave, int vcu, int G) {
    unsigned char* ws = (unsigned char*)lds_ptr(lds, 19);
    if (PART == 0 && vcu < 48) {
        const int l = vcu / 24, jc = vcu % 24;
        LAS float* cact = (LAS float*)lds;
        LAS float* part = (LAS float*)(lds + 32768);
        for (int i = tid; i < 8192; i += 512) { const int b = i >> 10, k = i & 1023; const float v = AP(1)[i]; cact[k * 8 + b] = silu_f(v); }
        __syncthreads();
        f32x4 acc[8];
#pragma unroll
        for (int b = 0; b < 8; ++b) acc[b] = (f32x4){0.f, 0.f, 0.f, 0.f};
        const float* wp = AP(2) + ((size_t)l * 1024 + wave * 128) * 6144 + jc * 256 + lane * 4;
#pragma unroll 16
        for (int k = 0; k < 128; ++k) { const f32x4 w4 = *(const f32x4*)(wp + (size_t)k * 6144);
            const f32x4 c0 = *(const LAS f32x4*)(cact + (wave * 128 + k) * 8), c1 = *(const LAS f32x4*)(cact + (wave * 128 + k) * 8 + 4);
            acc[0] += c0.x * w4; acc[1] += c0.y * w4; acc[2] += c0.z * w4; acc[3] += c0.w * w4; acc[4] += c1.x * w4; acc[5] += c1.y * w4; acc[6] += c1.z * w4; acc[7] += c1.w * w4; }
#pragma unroll
        for (int b = 0; b < 8; ++b) *(LAS f32x4*)(part + (wave * 8 + b) * 256 + lane * 4) = acc[b];
        __syncthreads();
        float* MOD = (float*)(ws + WS_MOD); const float* b_ada_ = AP(3);
        for (int i = tid; i < 2048; i += 512) { const int b = i >> 8, col = i & 255; float s = b_ada_[l * 6144 + jc * 256 + col];
#pragma unroll
            for (int w = 0; w < 8; ++w) s += part[(w * 8 + b) * 256 + col];
            MOD[(size_t)(l * 8 + b) * 6144 + jc * 256 + col] = s; }
        __syncthreads();
    }
    asm volatile("" ::: "memory");
    {
        const float* w_in_ = AP(5); const float* w_out_ = AP(10); const float* w_up_ = AP(13); const float* w_down_ = AP(16);
        LAS float* scr = (LAS float*)(lds + wave * 16384);
        const int gw = PART == 0 ? (vcu - 48) * NWAVES + wave : IT_IN + vcu * NWAVES + wave, NGW = (PART == 0 ? G - 48 : G) * NWAVES;
        for (int it = gw; it < (PART == 0 ? IT_IN : DEPTH * IT_LAYER) && it >= 0; it += NGW) {
            const int l = it / IT_LAYER; int r = it - l * IT_LAYER;
            unsigned char* wl = ws + WS_W + (size_t)l * W_LAYER;
            if (r < IT_IN) { const int nblk = NIN_COLS / 32, kb = r / nblk, nb = r % nblk; transpose_item(w_in_ + (size_t)l * DM * INW, DM, INW, (f16_t*)(wl + W_IN), 64 * kb, 32 * nb, 32 * nb, scr, lane); continue; } r -= IT_IN;
            if (r < IT_OUT) { const int kb = r / 32, nb = r % 32; colmax_item(w_out_ + (size_t)l * DM * DM, DM, (float*)(ws + WS_CTL) + CW_CMAX + l * CMAX_LAYER, 64 * kb, 32 * nb, lane); continue; } r -= IT_OUT;
            if (r < IT_UP) { const int nblk = FF2 / 32, kb = r / nblk, nb = r % nblk; colmax_item(w_up_ + (size_t)l * DM * FF2, FF2, (float*)(ws + WS_CTL) + CW_CMAX + l * CMAX_LAYER + DM, 64 * kb, 32 * nb, lane); continue; } r -= IT_UP;
            { const int kb = r / 32, nb = r % 32; transpose_item_f8(w_down_ + (size_t)l * FF * DM, FF, DM, (unsigned char*)(wl + W_DOWN), 64 * kb, 32 * nb, 32 * nb, pg8::WD_SCALE, scr, lane); }
        }
    }
    asm volatile("" ::: "memory");
    if (PART == 0) {
        float* ROPE = (float*)(ws + WS_ROPE);
        for (int i = vcu * 512 + tid; i < SEQ * 8; i += G * 512) { const int pos = i >> 3, j = i & 7;
            const float invf = j == 0 ? 1.0f : j == 1 ? 0.19392274474868576f : j == 2 ? 0.03760603093086393f : j == 3 ? 0.007292664737217109f : j == 4 ? 0.001414213562373095f :
                               j == 5 ? 0.0002742481756762073f : j == 6 ? 5.318295896944988e-05f : 1.031338537721246e-05f;
            const float ang = (float)pos * invf; const double rev = (double)ang * 0.15915494309189535; const float fr = (float)(rev - __builtin_floor(rev));
            ROPE[pos * 16 + j] = __builtin_amdgcn_cosf(fr); ROPE[pos * 16 + 8 + j] = __builtin_amdgcn_sinf(fr); }
    }
    if (vcu >= G - 64) {
        __syncthreads();
        const int item = vcu - (G - 64), l = PART, g = (item >> 4) & 3, kb = item & 15;
        LAS float* wpl = (LAS float*)lds;
        LAS float* wit = (LAS float*)(lds + 65536);
        const float* wps = AP(6) + (size_t)(l * 4 + g) * 128 * 128;
        for (int i = tid; i < 128 * 128 / 4; i += 512) *(LAS f32x4*)(wpl + 4 * i) = *(const f32x4*)(wps + 4 * i);
        const float* wis = AP(5) + (size_t)l * DM * INW + (size_t)(64 * kb) * INW + 1536 + 128 * g;
        for (int i = tid; i < 64 * 128; i += 512) { const int k = i >> 7, cc = i & 127; wit[k * 129 + cc] = wis[(size_t)k * INW + cc]; }
        __syncthreads();
        const int k = tid & 63, e0 = (tid >> 6) * 16;
        float accp[16];
#pragma unroll
        for (int e = 0; e < 16; ++e) accp[e] = 0.f;
        for (int cc = 0; cc < 128; ++cc) { const float wv = wit[k * 129 + cc];
#pragma unroll
            for (int e4 = 0; e4 < 4; ++e4) { const f32x4 p4 = *(const LAS f32x4*)(wpl + cc * 128 + e0 + 4 * e4); accp[4 * e4 + 0] += wv * p4.x; accp[4 * e4 + 1] += wv * p4.y; accp[4 * e4 + 2] += wv * p4.z; accp[4 * e4 + 3] += wv * p4.w; } }
        f16_t* WT = (f16_t*)(ws + WS_W + (size_t)l * W_LAYER + W_IN); const float* pscale_ = AP(7);
#pragma unroll
        for (int e = 0; e < 16; ++e) { const float ps = pscale_[l * PW + 128 * g + e0 + e]; WT[(size_t)(1536 + 128 * g + e0 + e) * DM + 64 * kb + k] = f2h(accp[e] * ps); }
        __syncthreads();
    }
}

__device__ __forceinline__ void unpk8(const v4u w, float (&v)[8]) { const f32x2 a = unpk(w.x), b = unpk(w.y), c = unpk(w.z), d = unpk(w.w); v[0] = a.x; v[1] = a.y; v[2] = b.x; v[3] = b.y; v[4] = c.x; v[5] = c.y; v[6] = d.x; v[7] = d.y; }
__device__ __forceinline__ v4u pk8(const float (&v)[8]) { v4u w; w.x = pkh(v[0], v[1]); w.y = pkh(v[2], v[3]); w.z = pkh(v[4], v[5]); w.w = pkh(v[6], v[7]); return w; }
__device__ __forceinline__ void ld8f(const float* p, float (&v)[8]) { const f32x4 a = *(const f32x4*)p, b = *(const f32x4*)(p + 4); v[0] = a.x; v[1] = a.y; v[2] = a.z; v[3] = a.w; v[4] = b.x; v[5] = b.y; v[6] = b.z; v[7] = b.w; }
__device__ __forceinline__ void st8f(float* p, const float (&v)[8]) { *(f32x4*)p = (f32x4){v[0], v[1], v[2], v[3]}; *(f32x4*)(p + 4) = (f32x4){v[4], v[5], v[6], v[7]}; }
__device__ __forceinline__ void ph_prologue2(LAS unsigned char* lds, int lane, int wave, int vcu, int G) {
    unsigned char* ws = (unsigned char*)lds_ptr(lds, 19); const float* w_out_ = AP(10);
    LAS float* scr = (LAS float*)(lds + wave * 16384);
    const int gw = vcu * NWAVES + wave, NGW = G * NWAVES;
    const float* w_up_ = AP(13);
    for (int it = gw; it < DEPTH * (IT_OUT + IT_UP); it += NGW) { const int l = it / (IT_OUT + IT_UP); int r = it - l * (IT_OUT + IT_UP); const float* cm = (const float*)(ws + WS_CTL) + CW_CMAX + l * CMAX_LAYER;
        if (r < IT_OUT) { const int kb = r / 32, nb = r % 32; transpose_item_i8(w_out_ + (size_t)l * DM * DM, DM, DM, ws + WS_W + (size_t)l * W_LAYER + W_OUT, 64 * kb, 32 * nb, 32 * nb, cm, scr, lane); continue; } r -= IT_OUT;
        { const int nblk = FF2 / 32, kb = r / nblk, nb = r % nblk; transpose_item_i8(w_up_ + (size_t)l * DM * FF2, DM, FF2, ws + WS_W + (size_t)l * W_LAYER + W_UP, 64 * kb, 32 * nb, up_row(32 * nb), cm + DM, scr, lane); } }
}
__device__ __forceinline__ float wave_maxd(float v) {
    v = fmaxf(v, WS_DPP(v, 0xB1)); v = fmaxf(v, WS_DPP(v, 0x4E)); v = fmaxf(v, WS_DPP(v, 0x141)); v = fmaxf(v, WS_DPP(v, 0x140));
    const int iv = __builtin_bit_cast(int, v);
    const float r0 = __builtin_bit_cast(float, __builtin_amdgcn_readlane(iv, 0)), r1 = __builtin_bit_cast(float, __builtin_amdgcn_readlane(iv, 16)),
                r2 = __builtin_bit_cast(float, __builtin_amdgcn_readlane(iv, 32)), r3 = __builtin_bit_cast(float, __builtin_amdgcn_readlane(iv, 48));
    return fmaxf(fmaxf(r0, r1), fmaxf(r2, r3));
}
__device__ __forceinline__ void ph_pre(const float* x, const float* g, const float* sc, const float* sh, f16_t* H, int row0, int lane) {
    float gm[2][8], sh8[2][8];
#pragma unroll
    for (int j = 0; j < 2; ++j) { float g8[8], s8[8]; ld8f(g + 512 * j + 8 * lane, g8); ld8f(sc + 512 * j + 8 * lane, s8); ld8f(sh + 512 * j + 8 * lane, sh8[j]);
#pragma unroll
        for (int e = 0; e < 8; ++e) gm[j][e] = g8[e] * (1.0f + s8[e]); }
    float v[2][8];
#pragma unroll
    for (int j = 0; j < 2; ++j) ld8f(x + (size_t)row0 * DM + 512 * j + 8 * lane, v[j]);
    for (int r = 0; r < 16; ++r) { const size_t row = (size_t)(row0 + r);
        float vn[2][8];
#pragma unroll
        for (int j = 0; j < 2; ++j)
#pragma unroll
            for (int e = 0; e < 8; ++e) vn[j][e] = v[j][e];
        if (r + 1 < 16) {
#pragma unroll
            for (int j = 0; j < 2; ++j) ld8f(x + (row + 1) * DM + 512 * j + 8 * lane, vn[j]);
        }
        float ss = 0.f;
#pragma unroll
        for (int j = 0; j < 2; ++j)
#pragma unroll
            for (int e = 0; e < 8; ++e) ss += v[j][e] * v[j][e];
        const float rstd = rsq(wave_sum(ss) * (1.0f / DM) + NORM_EPS);
#pragma unroll
        for (int j = 0; j < 2; ++j) { float o[8];
#pragma unroll
            for (int e = 0; e < 8; ++e) o[e] = v[j][e] * rstd * gm[j][e] + sh8[j][e];
            *(v4u*)(H + row * DM + 512 * j + 8 * lane) = pk8(o); }
#pragma unroll
        for (int j = 0; j < 2; ++j)
#pragma unroll
            for (int e = 0; e < 8; ++e) v[j][e] = vn[j][e];
    }
}
template <bool XIN16, bool XOUT16, bool HQ>
__device__ __forceinline__ void ph_post(const f16_t* Y, const void* xin_, void* xout_, const float* gpost, const float* gt, bool has_next, const float* gn, const float* scn, const float* shn, f16_t* H, float* SA, int row0, int hrow0, int lane) {
    float gg[2][8], gm[2][8], sh8[2][8];
#pragma unroll
    for (int j = 0; j < 2; ++j) { float a8[8], b8[8]; ld8f(gpost + 512 * j + 8 * lane, a8); ld8f(gt + 512 * j + 8 * lane, b8);
#pragma unroll
        for (int e = 0; e < 8; ++e) { gg[j][e] = a8[e] * b8[e]; gm[j][e] = 0.f; sh8[j][e] = 0.f; } }
    if (has_next) {
#pragma unroll
        for (int j = 0; j < 2; ++j) { float g8[8], s8[8]; ld8f(gn + 512 * j + 8 * lane, g8); ld8f(scn + 512 * j + 8 * lane, s8); ld8f(shn + 512 * j + 8 * lane, sh8[j]);
#pragma unroll
            for (int e = 0; e < 8; ++e) gm[j][e] = g8[e] * (1.0f + s8[e]); }
    }
    const float* xin32 = (const float*)xin_; const f16_t* xin16 = (const f16_t*)xin_; float* xout32 = (float*)xout_; f16_t* xout16 = (f16_t*)xout_;
    auto ldx = [&](size_t row, int j, float (&o)[8]) { if (XIN16) unpk8(*(const v4u*)(xin16 + row * DM + 512 * j + 8 * lane), o); else ld8f(xin32 + row * DM + 512 * j + 8 * lane, o); };
    v4u yw[2]; float xv[2][8];
#pragma unroll
    for (int j = 0; j < 2; ++j) { yw[j] = *(const v4u*)(Y + (size_t)row0 * DM + 512 * j + 8 * lane); ldx((size_t)row0, j, xv[j]); }
    for (int r = 0; r < 16; ++r) { const size_t row = (size_t)(row0 + r);
        v4u ywn[2]; float xvn[2][8];
#pragma unroll
        for (int j = 0; j < 2; ++j) { ywn[j] = yw[j];
#pragma unroll
            for (int e = 0; e < 8; ++e) xvn[j][e] = xv[j][e]; }
        if (r + 1 < 16) {
#pragma unroll
            for (int j = 0; j < 2; ++j) { ywn[j] = *(const v4u*)(Y + (row + 1) * DM + 512 * j + 8 * lane); ldx(row + 1, j, xvn[j]); }
        }
        float y[2][8]; float ss = 0.f;
#pragma unroll
        for (int j = 0; j < 2; ++j) { unpk8(yw[j], y[j]);
#pragma unroll
            for (int e = 0; e < 8; ++e) ss += y[j][e] * y[j][e]; }
        const float rstd = rsq(wave_sum(ss) * (1.0f / DM) + NORM_EPS); float s2 = 0.f;
#pragma unroll
        for (int j = 0; j < 2; ++j) {
#pragma unroll
            for (int e = 0; e < 8; ++e) xv[j][e] = xv[j][e] + y[j][e] * rstd * gg[j][e];
            if (XOUT16) { const v4u w = pk8(xv[j]); *(v4u*)(xout16 + row * DM + 512 * j + 8 * lane) = w; unpk8(w, xv[j]); }
            else st8f(xout32 + row * DM + 512 * j + 8 * lane, xv[j]);
#pragma unroll
            for (int e = 0; e < 8; ++e) s2 += xv[j][e] * xv[j][e]; }
        if (has_next) { const float r2 = rsq(wave_sum(s2) * (1.0f / DM) + NORM_EPS);
            if (HQ) { float o[2][8]; float mx = 0.f;
#pragma unroll
                for (int j = 0; j < 2; ++j)
#pragma unroll
                    for (int e = 0; e < 8; ++e) { o[j][e] = xv[j][e] * r2 * gm[j][e] + sh8[j][e]; mx = fmaxf(mx, fabsf(o[j][e])); }
                mx = fmaxf(wave_maxd(mx), 1e-20f); const float inv = 127.0f / mx; unsigned char* H8 = (unsigned char*)H + (size_t)(hrow0 + r) * DM;
                *(v2u*)(H8 + 8 * lane) = pk8_i8(o[0], inv); *(v2u*)(H8 + 512 + 8 * lane) = pk8_i8(o[1], inv);
                if (lane == 0) SA[row] = mx * (1.0f / 127.0f);
            } else {
#pragma unroll
            for (int j = 0; j < 2; ++j) { float o[8];
#pragma unroll
                for (int e = 0; e < 8; ++e) o[e] = xv[j][e] * r2 * gm[j][e] + sh8[j][e];
                *(v4u*)(H + row * DM + 512 * j + 8 * lane) = pk8(o); } } }
#pragma unroll
        for (int j = 0; j < 2; ++j) { yw[j] = ywn[j];
#pragma unroll
            for (int e = 0; e < 8; ++e) xv[j][e] = xvn[j][e]; }
    }
}
__device__ __forceinline__ void ph_merge(const Args& a, int l, const f16_t* AO, const f16_t* R, unsigned char* MG8, float* SA, LAS float* scr, int row0, int lane) {
    float ag[8], pg[8], psc[8];
#pragma unroll
    for (int e = 0; e < 8; ++e) { ag[e] = a.attn_out_gain[l * AW + 8 * lane + e]; pg[e] = a.pool_out_gain[l * PW + 8 * lane + e]; psc[e] = a.pool_scale[l * PW + 8 * lane + e]; }
    const int g = lane >> 4, w = 2 << g;
    float sum[8];
#pragma unroll
    for (int e = 0; e < 8; ++e) sum[e] = 0.f;
    { const int t0 = (int)(row0 & (SEQ - 1));
        for (int i = 1; i <= 16; ++i) { if (i <= w && t0 - i >= 0) { float pv[8]; unpk8(*(const v4u*)(R + (size_t)(row0 - i) * PW + 8 * lane), pv);
#pragma unroll
                for (int e = 0; e < 8; ++e) sum[e] += pv[e]; } } }
    const v4u zero4 = (v4u){0u, 0u, 0u, 0u};
    v4u aw = *(const v4u*)(AO + (size_t)row0 * AW + 8 * lane), pw = *(const v4u*)(R + (size_t)row0 * PW + 8 * lane), ow = zero4;
    if ((int)(row0 & (SEQ - 1)) - w >= 0) ow = *(const v4u*)(R + (size_t)(row0 - w) * PW + 8 * lane);
    for (int r = 0; r < 16; ++r) { const size_t row = (size_t)(row0 + r); const int tpos = (int)(row & (SEQ - 1));
        v4u awn = aw, pwn = pw, own = zero4;
        if (r + 1 < 16) { awn = *(const v4u*)(AO + (row + 1) * AW + 8 * lane); pwn = *(const v4u*)(R + (row + 1) * PW + 8 * lane);
            if (tpos + 1 - w >= 0) own = *(const v4u*)(R + (row + 1 - w) * PW + 8 * lane); }
        float av[8]; unpk8(aw, av);
        float pt[8]; unpk8(pw, pt);
        float pold[8]; unpk8(ow, pold);
        aw = awn; pw = pwn; ow = own;
        float ss = 0.f;
#pragma unroll
        for (int e = 0; e < 8; ++e) ss += av[e] * av[e];
        const float ra = rsq(wave_sum(ss) * (1.0f / AW) + NORM_EPS);
#pragma unroll
        for (int e = 0; e < 8; ++e) av[e] = av[e] * ra * ag[e];
        const int cnt = (tpos + 1) < w ? (tpos + 1) : w;
#pragma unroll
        for (int e = 0; e < 8; ++e) sum[e] += pt[e] - pold[e];
        const float ic = 1.0f / (float)cnt; float po[8];
#pragma unroll
        for (int e = 0; e < 8; ++e) po[e] = sum[e] * ic - pt[e];
        float s2 = 0.f;
#pragma unroll
        for (int e = 0; e < 8; ++e) s2 += po[e] * po[e];
        const float rp = rsq(wave_sum(s2) * (1.0f / PW) + NORM_EPS);
#pragma unroll
        for (int e = 0; e < 8; ++e) po[e] = po[e] * rp * pg[e];
        float mx = 0.f;
#pragma unroll
        for (int e = 0; e < 8; ++e) mx = fmaxf(mx, fmaxf(fabsf(av[e]), fabsf(po[e])));
        mx = fmaxf(wave_maxd(mx), 1e-20f); const float inv = 127.0f / mx;
        *(v2u*)(MG8 + row * DM + 8 * lane) = pk8_i8(av, inv); *(v2u*)(MG8 + row * DM + AW + 8 * lane) = pk8_i8(po, inv);
        if (lane == 0) SA[row] = mx * (1.0f / 127.0f);
    }
}


__device__ __forceinline__ void ph_gate(unsigned char* ws, const f16_t* Q, LAS unsigned char* lds, int tid, int rowbase, int lrowbase) {
    const float* KP = (const float*)(ws + WS_KP); unsigned* SEL = (unsigned*)(ws + WS_SEL);
    const int b = rowbase >> 12, qb = (rowbase & (SEQ - 1)) >> 8;
    LAS float* kms = (LAS float*)lds;
    for (int i = tid; i < qb * 128; i += 512) { const int n = i >> 7, c4 = (i & 127) * 4; const float* kp = KP + ((size_t)(b * NBLK + n)) * 512 + c4;
        const f32x4 v = *(const f32x4*)kp + *(const f32x4*)(kp + 128 * 512); *(LAS f32x4*)(kms + n * 544 + (c4 >> 6) * 68 + (c4 & 63)) = v; }
    __syncthreads();
    const float NEG = -__builtin_inff();
#pragma unroll
    for (int it = 0; it < 2; ++it) { const int pair = tid + 512 * it, r = pair >> 3, h = pair & 7; const size_t row = (size_t)(rowbase + r);
        f32x2 qf[32];
#pragma unroll
        for (int c = 0; c < 8; ++c) { const v4u qw = *(const v4u*)(Q + (size_t)(lrowbase + r) * AW + h * HD + 8 * c); qf[4 * c] = unpk(qw.x); qf[4 * c + 1] = unpk(qw.y); qf[4 * c + 2] = unpk(qw.z); qf[4 * c + 3] = unpk(qw.w); }
        float g1 = NEG, g2 = NEG, g3 = NEG; int i1 = -1, i2 = -1, i3 = -1;
        for (int n = 0; n < qb; ++n) { const LAS float* kp = kms + n * 544 + h * 68; f32x2 ga = (f32x2){0.f, 0.f}, gb = ga;
#pragma unroll
            for (int c = 0; c < 8; ++c) { const f32x4 k0 = *(const LAS f32x4*)(kp + 8 * c), k1 = *(const LAS f32x4*)(kp + 8 * c + 4);
                ga += qf[4 * c] * (f32x2){k0.x, k0.y}; gb += qf[4 * c + 1] * (f32x2){k0.z, k0.w}; ga += qf[4 * c + 2] * (f32x2){k1.x, k1.y}; gb += qf[4 * c + 3] * (f32x2){k1.z, k1.w}; }
            const float g = (ga.x + ga.y) + (gb.x + gb.y);
            if (g > g1) { g3 = g2; i3 = i2; g2 = g1; i2 = i1; g1 = g; i1 = n; } else if (g > g2) { g3 = g2; i3 = i2; g2 = g; i2 = n; } else if (g > g3) { g3 = g; i3 = n; } }
        unsigned m = 0u; if (i1 >= 0) m |= 1u << i1; if (i2 >= 0) m |= 1u << i2; if (i3 >= 0) m |= 1u << i3;
        SEL[row * NH + h] = m; }
    __syncthreads();
}


__device__ __forceinline__ void ph_fix(const Args& a, int l, unsigned char* ACT, int g0, int ng, int gtid, int NT) {
    const float* BND = (const float*)(a.ws + WS_BND);
    const float* cw = a.conv_w + (size_t)l * 3 * FF2; const float* cb = a.conv_b + (size_t)l * FF2;
    for (int it = gtid; it < ng * (FF / 4); it += NT) { const int grp = g0 + it / (FF / 4), j = (it % (FF / 4)) * 4;
        f32x4 uc0[2], uc1[2];
#pragma unroll
        for (int p = 0; p < 2; ++p) { const int col = p * FF + j;
            const f32x4 u0 = *(const f32x4*)(BND + ((size_t)grp * 4 + 0) * FF2 + col), u1 = *(const f32x4*)(BND + ((size_t)grp * 4 + 1) * FF2 + col);
            f32x4 p2 = (f32x4){0.f, 0.f, 0.f, 0.f}, p3 = p2;
            if ((grp & 31) != 0) { p2 = *(const f32x4*)(BND + ((size_t)(grp - 1) * 4 + 2) * FF2 + col); p3 = *(const f32x4*)(BND + ((size_t)(grp - 1) * 4 + 3) * FF2 + col); }
            const f32x4 w0 = *(const f32x4*)(cw + col), w1 = *(const f32x4*)(cw + FF2 + col), w2 = *(const f32x4*)(cw + 2 * FF2 + col), b4 = *(const f32x4*)(cb + col);
            uc0[p] = b4 + w0 * p2 + w1 * p3 + w2 * u0; uc1[p] = b4 + w0 * p3 + w1 * u0 + w2 * u1; }
        const float sa = pg8::ACT_SCALE;
        const unsigned o0 = pg8::pk4_fp8(silu_f(uc0[0].x) * uc0[1].x * sa, silu_f(uc0[0].y) * uc0[1].y * sa, silu_f(uc0[0].z) * uc0[1].z * sa, silu_f(uc0[0].w) * uc0[1].w * sa);
        const unsigned o1 = pg8::pk4_fp8(silu_f(uc1[0].x) * uc1[1].x * sa, silu_f(uc1[0].y) * uc1[1].y * sa, silu_f(uc1[0].z) * uc1[1].z * sa, silu_f(uc1[0].w) * uc1[1].w * sa);
        *(unsigned*)(ACT + ((size_t)(grp - g0) * 128 + 0) * FF + j) = o0; *(unsigned*)(ACT + ((size_t)(grp - g0) * 128 + 1) * FF + j) = o1; }
}
#ifndef NSPLIT
#define NSPLIT 2
#endif
#ifndef SKEW_US
#define SKEW_US 0
#endif
constexpr int GS = 256 / NSPLIT, MGRP = M / NSPLIT;
#define IN(k) (lo <= (k) && (k) < hi)
#define LANE_IDS const int tid = hw_tid(); const int lane = tid & 63, wave = __builtin_amdgcn_readfirstlane(tid >> 6); const int row0 = (int)rb + vcu * 128 + wave * 16; (void)lane; (void)row0;
#define GROUP_BAR() do { XcdBarrier b_; b_.bar = (unsigned*)(wsp + WS_CTL) + CW_BAR + (1 + (int)(rb / MGRP)) * XCD_BAR_WORDS; b_.x = xb_xcc_id(); b_.gsize = (unsigned)GS; b_.st = (volatile LAS unsigned*)(lds + MISC_OFF) + 10; xcd_barrier(b_); } while (0)
#define SEAM(k) do { if (IN((k) + 1)) GROUP_BAR(); } while (0)
template <int L> __device__ __forceinline__ void layer_phases(LAS unsigned char* lds, unsigned char* ldsg, int vcu, int bxl, size_t rb, int lo, int hi) {
    constexpr int l = L; constexpr int pb = PH_L0 + L * NPL;
    if (pb >= hi || pb + NPL <= lo) return;
    constexpr size_t GT = (size_t)MGRP * AW * 2;
    static_assert((size_t)MGRP * FF * 2 <= 5 * GT + (size_t)MGRP * DM * 2, "ACT fits its group's region");
#define LPTRS unsigned char* ws = (unsigned char*)lds_ptr(lds, 19); unsigned char* wsp = ws; const int bat = (int)((rb + (size_t)vcu * 128) >> 12); const float* MOD = (const float*)(ws + WS_MOD); \
    f16_t* H = (f16_t*)(ws + WS_H); f16_t* Y = (f16_t*)(ws + WS_Y); unsigned char* wl = ws + WS_W + (size_t)l * W_LAYER; unsigned char* ra = ws + WS_A + (rb / MGRP) * (5 * GT + (size_t)MGRP * DM * 2); \
    f16_t* Qg = (f16_t*)ra; f16_t* Kg = (f16_t*)(ra + GT); f16_t* Vg = (f16_t*)(ra + 2 * GT); f16_t* Rg = (f16_t*)(ra + 3 * GT); f16_t* AOg = (f16_t*)(ra + 4 * GT); unsigned char* MG8g = ra + 5 * GT; unsigned char* ACTg = ra; \
    const float* md = MOD + (size_t)(l * 8 + bat) * 6144;            \
    (void)wsp; (void)H; (void)Y; (void)wl; (void)Qg; (void)Kg; (void)Vg; (void)Rg; (void)AOg; (void)MG8g; (void)ACTg; (void)md;
    if (IN(pb + J_G1)) { LPTRS
        pg8::Gemm g{H + rb * DM, (const f16_t*)(wl + W_IN), MGRP, INW, DM}; pg8::StaticOrder S; S.init(MGRP, INW, GS, bxl);
        pg8::EpiIn E{Qg, (const float*)(ws + WS_ROPE), (float*)(ws + WS_KP) + (rb >> 8) * 512, QSCALE, GT / 2};
        pg8::gemm_phase<pg8::EpiIn, pg8::StaticOrder, true, true>(lds + RING_OFF, g, S, E);
        SEAM(pb + J_G1);
    }
    if (IN(pb + J_GATE)) { LPTRS LANE_IDS ph_gate(ws, Qg, lds, tid, (int)rb + vcu * 128, vcu * 128); SEAM(pb + J_GATE); }
    if (IN(pb + J_ATT)) { LPTRS
        static_assert(attn_body::ATTN_LDS_BYTES <= RING_BYTES && attn_body::ATTN_PITCH == AW, "attention body geometry vs frame");
        const attn_body::AttnTensors AT{(const attn_body::f16*)Qg, (const attn_body::f16*)Kg, (const attn_body::f16*)Vg, (attn_body::f16*)AOg, (const unsigned*)(ws + WS_SEL) + rb * NH};
        const attn_body::StaticOrder AS(GS, bxl);
        attn_body::attn_phase<attn_body::StaticOrder>((char*)ldsg + RING_OFF, AT, AS);
        SEAM(pb + J_ATT);
    }
    if (IN(pb + J_MERGE)) { LPTRS LANE_IDS const Args args = lds_args(lds); ph_merge(args, l, AOg, Rg, MG8g, (float*)(ws + WS_SAM) + rb, (LAS float*)(lds + wave * 4096), vcu * 128 + wave * 16, lane); SEAM(pb + J_MERGE); }
    if (IN(pb + J_G2)) { LPTRS
        if (L == 0 && NSPLIT > 1 && rb / MGRP != NSPLIT - 1) {
            if (hw_tid() == 0) { unsigned* bar = (unsigned*)(ws + WS_CTL) + CW_BAR; unsigned* wf = (unsigned*)(ws + WS_CTL) + CW_WFLAG;
                XB_SPIN(xb_ld(wf) == 0u, bar);
                __builtin_amdgcn_fence(__ATOMIC_ACQUIRE, "agent"); asm volatile("s_waitcnt vmcnt(0)" ::: "memory"); }
            __syncthreads(); }
        pg8::Gemm g{(const f16_t*)MG8g, (const f16_t*)(wl + W_OUT), MGRP, DM, DM / 2}; pg8::StaticOrder S; S.init(MGRP, DM, GS, bxl);
        pg8::EpiI8F16 E{Y + rb * DM, DM, (const float*)(ws + WS_SAM) + rb, (const float*)(ws + WS_CTL) + CW_CMAX + l * CMAX_LAYER};
        pg8::gemm_phase<pg8::EpiI8F16, pg8::StaticOrder, true, true, 2>(lds + RING_OFF, g, S, E);
        SEAM(pb + J_G2);
    }
    if (IN(pb + J_POST1)) { LPTRS LANE_IDS const Args args = lds_args(lds); ph_post<(L > 0), true, true>(Y, L == 0 ? (const void*)args.x : (const void*)(ws + WS_X16), (void*)(ws + WS_X16), args.g_post_mix + l * DM, md + 2048, true, args.g_pre_ffn + l * DM, md + 4096, md + 3072, H + rb * DM, (float*)(ws + WS_SAH), row0, vcu * 128 + wave * 16, lane); SEAM(pb + J_POST1); }
    if (IN(pb + J_G3)) { LPTRS
        const Args args = lds_args(lds);
        pg8::Gemm g{H + rb * DM, (const f16_t*)(wl + W_UP), MGRP, FF2, DM / 2}; pg8::StaticOrder S; S.init(MGRP, FF2, GS, bxl);
        pg8::EpiUp E{ACTg, (float*)(ws + WS_BND) + (rb >> 7) * 4 * FF2, args.conv_w + (size_t)l * 3 * FF2, args.conv_b + (size_t)l * FF2, (const float*)(ws + WS_SAH) + rb, (const float*)(ws + WS_CTL) + CW_CMAX + l * CMAX_LAYER + DM, (LAS float*)(lds + EPI_LDS_OFF)};
        pg8::gemm_phase<pg8::EpiUp, pg8::StaticOrder, true, true, 2>(lds + RING_OFF, g, S, E);
        SEAM(pb + J_G3);
    }
    if (IN(pb + J_FIX)) { LPTRS LANE_IDS const Args args = lds_args(lds); ph_fix(args, l, ACTg, (int)(rb >> 7), MGRP / 128, bxl * 512 + tid, GS * 512); SEAM(pb + J_FIX); }
    if (IN(pb + J_G4)) { LPTRS
        pg8::Gemm g{(const f16_t*)ACTg, (const f16_t*)(wl + W_DOWN), MGRP, DM, FF / 2}; pg8::StaticOrder S; S.init(MGRP, DM, GS, bxl);
        pg8::EpiF16 E{Y + rb * DM, DM, 0, 0, 1.0f / (pg8::ACT_SCALE * pg8::WD_SCALE)};
        pg8::gemm_phase<pg8::EpiF16, pg8::StaticOrder, true, true, 1>(lds + RING_OFF, g, S, E);
        SEAM(pb + J_G4);
    }
    if (IN(pb + J_POST2)) { LPTRS LANE_IDS const Args args = lds_args(lds); const bool nx = (l + 1 < DEPTH); const float* mdn = MOD + (size_t)((nx ? l + 1 : l) * 8 + bat) * 6144;
        ph_post<true, (L + 1 < DEPTH), false>(Y, (const void*)(ws + WS_X16), (L + 1 < DEPTH) ? (void*)(ws + WS_X16) : (void*)args.out, args.g_post_ffn + l * DM, md + 5120, nx, args.g_pre_mix + (nx ? l + 1 : l) * DM, mdn + 1024, mdn, H, (float*)nullptr, row0, 0, lane); SEAM(pb + J_POST2); }
}
__global__ void __launch_bounds__(NWAVES * 64, 2) fwd_kernel(Args args) {
    extern __shared__ __attribute__((aligned(16))) unsigned char lds_raw[];
    LAS unsigned char* lds = (LAS unsigned char*)lds_raw;
    volatile LAS unsigned* MISC = (volatile LAS unsigned*)(lds + MISC_OFF);
    const int G = gridDim.x; const int bx = blockIdx.x;
    const int grp = bx / GS, bxl = bx % GS;
    const int vcu = (bxl % 8) * (GS / 8) + bxl / 8;
    const size_t rb = (size_t)grp * MGRP;
    unsigned char* ws = args.ws;
    gu32* ctl = (gu32*)(ws + WS_CTL);
    for (int u = threadIdx.x; u < (LDS_BYTES - LDSCTL_OFF) / 4; u += NWAVES * 64) ((LAS unsigned*)(lds + LDSCTL_OFF))[u] = 0u;
    __syncthreads();
    if ((threadIdx.x & 63) == 0) ((LAS unsigned*)(lds + (HWTID_LDS_ADDR - 131072) + LDSCTL_OFF))[(unsigned)__builtin_amdgcn_s_getreg(((6 - 1) << 11) | 4)] = threadIdx.x >> 6;
    if (threadIdx.x == 0) { LAS unsigned long long* la = (LAS unsigned long long*)(lds + ARGS_OFF);
        la[0] = (unsigned long long)args.x; la[1] = (unsigned long long)args.c; la[2] = (unsigned long long)args.w_ada; la[3] = (unsigned long long)args.b_ada; la[4] = (unsigned long long)args.g_pre_mix;
        la[5] = (unsigned long long)args.w_in; la[6] = (unsigned long long)args.w_pool; la[7] = (unsigned long long)args.pool_scale; la[8] = (unsigned long long)args.attn_out_gain; la[9] = (unsigned long long)args.pool_out_gain;
        la[10] = (unsigned long long)args.w_out; la[11] = (unsigned long long)args.g_post_mix; la[12] = (unsigned long long)args.g_pre_ffn; la[13] = (unsigned long long)args.w_up; la[14] = (unsigned long long)args.conv_w;
        la[15] = (unsigned long long)args.conv_b; la[16] = (unsigned long long)args.w_down; la[17] = (unsigned long long)args.g_post_ffn; la[18] = (unsigned long long)args.out; la[19] = (unsigned long long)args.ws; }
    __syncthreads();
    { unsigned* bwords = (unsigned*)(ctl + CW_BAR); (void)xcd_barrier_post(bwords, MISC + 8, (unsigned)G); (void)xcd_barrier_post(bwords + (1 + grp) * XCD_BAR_WORDS, MISC + 10, (unsigned)GS); }
#define GRID_BAR() do { XcdBarrier b_; b_.bar = (unsigned*)(ws + WS_CTL) + CW_BAR; b_.x = xb_xcc_id(); b_.gsize = (unsigned)G; b_.st = MISC + 8; xcd_barrier(b_); } while (0)
    const int lo = args.ph_lo, hi = args.ph_hi;
    const float* MOD = (const float*)(ws + WS_MOD);
    f16_t* H = (f16_t*)(ws + WS_H);

    unsigned char* wsp = ws;
    if (IN(PH_PRO)) { const int tid = hw_tid(); const int lane = tid & 63, wave = __builtin_amdgcn_readfirstlane(tid >> 6);
        const int vcug = (G % 8 == 0) ? (bx % 8) * (G / 8) + bx / 8 : bx;
        ph_prologue<0>(lds, tid, lane, wave, vcug, G);
        if (IN(PH_PRO + 1)) GRID_BAR(); }
    if (IN(PH_PRO2) && grp == NSPLIT - 1) { const int tid = hw_tid(); const int lane = tid & 63, wave = __builtin_amdgcn_readfirstlane(tid >> 6);
        ph_prologue<1>(lds, tid, lane, wave, vcu, GS);
        GROUP_BAR();
        ph_prologue2(lds, lane, wave, vcu, GS);
        if (SKEW_US > 0) { const unsigned long long t0 = __builtin_amdgcn_s_memrealtime(); while (__builtin_amdgcn_s_memrealtime() - t0 < (unsigned long long)(SKEW_US * 100)) __builtin_amdgcn_s_sleep(16); } }
    if (IN(PH_PRE)) { LANE_IDS const Args la = lds_args(lds); const int bat = row0 >> 12; const float* md = MOD + (size_t)(0 * 8 + bat) * 6144; ph_pre(la.x, la.g_pre_mix, md + 1024, md, H, row0, lane); SEAM(PH_PRE); }
    if (grp == NSPLIT - 1 && bxl == 0 && hw_tid() == 0) __hip_atomic_store((unsigned*)(ws + WS_CTL) + CW_WFLAG, 1u, __ATOMIC_RELEASE, __HIP_MEMORY_SCOPE_AGENT);

    layer_phases<0>(lds, lds_raw, vcu, bxl, rb, lo, hi);
    layer_phases<1>(lds, lds_raw, vcu, bxl, rb, lo, hi);
}
#undef IN
#undef SEAM
#undef LPTRS


static void launch_range(const Args& base, int lo, int hi, int li, int chunk, hipStream_t stream) {
    Args a = base; a.ph_lo = lo; a.ph_hi = hi; a.li = li; a.chunk = chunk;
    hipLaunchKernelGGL(fwd_kernel, dim3(256), dim3(NWAVES * 64), LDS_BYTES, stream, a);
    const hipError_t le = hipPeekAtLastError();
    if (le != hipSuccess) fprintf(stderr, "kernel_launch: launch [%d,%d) failed: %s\n", lo, hi, hipGetErrorName(le));
}
extern "C" void kernel_launch(void* const* d_in, const int* in_sizes, int n_in, void* d_out, int out_size, void* d_ws, size_t ws_size, hipStream_t stream) {
    static int ready = 0;
    if (ready == 0) {
        if (n_in != 18 || in_sizes[0] != M * DM || out_size != M * DM || ws_size < WS_END) { fprintf(stderr, "kernel_launch: unexpected shapes (n_in %d, in0 %d, out %d, ws %zu); nothing launched\n", n_in, n_in > 0 ? in_sizes[0] : -1, out_size, ws_size); ready = -1; return; }
        if (hipFuncSetAttribute((const void*)fwd_kernel, hipFuncAttributeMaxDynamicSharedMemorySize, LDS_BYTES) != hipSuccess) { fprintf(stderr, "kernel_launch: hipFuncSetAttribute failed\n"); ready = -1; return; }
        int per_cu = 0;
        if (hipOccupancyMaxActiveBlocksPerMultiprocessor(&per_cu, (const void*)fwd_kernel, NWAVES * 64, LDS_BYTES) != hipSuccess || per_cu < 1) fprintf(stderr, "kernel_launch: note: occupancy query reports %d workgroups per CU\n", per_cu);
        (void)hipGetLastError();
        ready = 1;
    }
    if (ready < 0) return;
    if (hipMemsetAsync((char*)d_ws + WS_CTL, 0, CTL_ZERO_BYTES, stream) != hipSuccess) { fprintf(stderr, "kernel_launch: hipMemsetAsync failed\n"); return; }
    Args a{};
    a.x = (const float*)d_in[0]; a.c = (const float*)d_in[1]; a.w_ada = (const float*)d_in[2]; a.b_ada = (const float*)d_in[3]; a.g_pre_mix = (const float*)d_in[4]; a.w_in = (const float*)d_in[5];
    a.w_pool = (const float*)d_in[6]; a.pool_scale = (const float*)d_in[7]; a.attn_out_gain = (const float*)d_in[8]; a.pool_out_gain = (const float*)d_in[9]; a.w_out = (const float*)d_in[10];
    a.g_post_mix = (const float*)d_in[11]; a.g_pre_ffn = (const float*)d_in[12]; a.w_up = (const float*)d_in[13]; a.conv_w = (const float*)d_in[14]; a.conv_b = (const float*)d_in[15];
    a.w_down = (const float*)d_in[16]; a.g_post_ffn = (const float*)d_in[17];
    a.out = (float*)d_out; a.ws = (unsigned char*)d_ws;
    launch_range(a, 0, NPH, 0, 0, stream);
}
```
